# Optimizing an MI355X kernel written in HIP

```python
import jax, jax.numpy as jnp
from jax import lax
import numpy as np

D_MODEL = 1024
BATCH = 16
SEQ = 4096
DEPTH = 4

D_MIX = 2 * D_MODEL
D_MLSTM = D_MIX // 2
N_MLSTM_HEADS = 4
DV_HEAD = D_MLSTM // N_MLSTM_HEADS
DQK_HEAD = DV_HEAD // 2
D_QK = N_MLSTM_HEADS * DQK_HEAD
D_CONV = D_MIX - D_MLSTM
N_CONV_GROUPS = 16
CONV_WIDTH = 3
CHUNK = 64
EPS = 1e-6

SPLIT_SIZES = (D_QK, D_QK, D_MLSTM, D_MLSTM, D_MLSTM, N_MLSTM_HEADS, N_MLSTM_HEADS,
               D_CONV, D_CONV, D_CONV, D_CONV)
IN_COLS = 2 * D_QK + 3 * D_MLSTM + 2 * N_MLSTM_HEADS + 4 * D_CONV

kernel_name = "hymba_mlstm_shortconv_hybrid"


def _split_points():
    pts = []
    acc = 0
    for s in SPLIT_SIZES[:-1]:
        acc += s
        pts.append(acc)
    return tuple(pts)


def rms_norm(x, g):
    xf = x.astype(jnp.float32)
    y = xf * lax.rsqrt(jnp.mean(xf * xf, axis=-1, keepdims=True) + EPS)
    return (y * g.astype(jnp.float32)).astype(x.dtype)


def group_rms_norm(x, g, n_groups, out_dtype):
    shp = x.shape
    xf = x.astype(jnp.float32).reshape(shp[:-1] + (n_groups, shp[-1] // n_groups))
    xf = xf * lax.rsqrt(jnp.mean(xf * xf, axis=-1, keepdims=True) + EPS)
    return (xf.reshape(shp) * g.astype(jnp.float32)).astype(out_dtype)


def mlstm_chunkwise(q, k, v, log_i, log_f):
    B_, H_, S_, dk = q.shape
    dv = v.shape[-1]
    nc = S_ // CHUNK

    def to_chunks(t):
        t = t.reshape((B_, H_, nc, CHUNK) + t.shape[3:])
        return jnp.moveaxis(t, 2, 0)

    qc = to_chunks(q.astype(jnp.float32))
    kc = to_chunks(k.astype(jnp.float32))
    vc = to_chunks(v.astype(jnp.float32))
    lic = to_chunks(log_i)
    bc = lax.cumsum(to_chunks(log_f), axis=3)
    causal = jnp.tril(jnp.ones((CHUNK, CHUNK), dtype=bool))

    def step(carry, xs):
        C, n, m = carry
        qx, kx, vx, li, b = xs
        D = b[..., :, None] - b[..., None, :] + li[..., None, :]
        D = jnp.where(causal, D, -jnp.inf)
        inter = b + m[..., None]
        m_comb = jnp.maximum(inter, jnp.max(D, axis=-1))
        Dw = jnp.exp(D - m_comb[..., None])
        inter_w = jnp.exp(inter - m_comb)
        s = jnp.einsum('bhtd,bhsd->bhts', qx, kx) * Dw
        num = (jnp.einsum('bhts,bhsv->bhtv', s, vx)
               + inter_w[..., None] * jnp.einsum('bhtd,bhdv->bhtv', qx, C))
        den = jnp.sum(s, axis=-1) + inter_w * jnp.einsum('bhtd,bhd->bht', qx, n)
        h = num / jnp.maximum(jnp.abs(den), jnp.exp(-m_comb))[..., None]
        bL = b[..., -1]
        a = bL[..., None] - b + li
        m_new = jnp.maximum(bL + m, jnp.max(a, axis=-1))
        decay = jnp.exp(bL + m - m_new)
        w = jnp.exp(a - m_new[..., None])
        kw = kx * w[..., None]
        C_new = decay[..., None, None] * C + jnp.einsum('bhsd,bhsv->bhdv', kw, vx)
        n_new = decay[..., None] * n + jnp.sum(kw, axis=2)
        return (C_new, n_new, m_new), h

    init = (jnp.zeros((B_, H_, dk, dv), jnp.float32),
            jnp.zeros((B_, H_, dk), jnp.float32),
            jnp.zeros((B_, H_), jnp.float32))
    _, hs = lax.scan(step, init, (qc, kc, vc, lic, bc))
    return jnp.moveaxis(hs, 0, 2).reshape(B_, H_, S_, dv)


def causal_depthwise_conv(u, w):
    S_ = u.shape[1]
    up = jnp.pad(u, ((0, 0), (CONV_WIDTH - 1, 0), (0, 0)))
    y = w[0] * up[:, 0:S_]
    for j in range(1, CONV_WIDTH):
        y = y + w[j] * up[:, j:j + S_]
    return y


def hybrid_layer(x, g_pre, g_post, w_in, b_i, b_f, g_head, conv_w, g_conv, w_out):
    B_, S_, _ = x.shape
    h = rms_norm(x, g_pre)
    proj = jnp.einsum('bsd,de->bse', h, w_in)
    q, k, v, o, z_m, i_pre, f_pre, u, gate_b, gate_c, z_c = jnp.split(
        proj, _split_points(), axis=-1)

    def heads(t, dh):
        return t.reshape(B_, S_, N_MLSTM_HEADS, dh).transpose(0, 2, 1, 3)

    qh = heads(q, DQK_HEAD) * (DQK_HEAD ** -0.5)
    kh = heads(k, DQK_HEAD)
    vh = heads(v, DV_HEAD)
    log_i = (i_pre.astype(jnp.float32) + b_i.astype(jnp.float32)).transpose(0, 2, 1)
    log_f = jax.nn.log_sigmoid(
        f_pre.astype(jnp.float32) + b_f.astype(jnp.float32)).transpose(0, 2, 1)
    hm = mlstm_chunkwise(qh, kh, vh, log_i, log_f)
    hm = hm.transpose(0, 2, 1, 3).reshape(B_, S_, D_MLSTM)
    hm = group_rms_norm(hm, g_head, N_MLSTM_HEADS, x.dtype)
    y_m = jax.nn.silu(z_m) * jax.nn.sigmoid(o) * hm

    conv = causal_depthwise_conv(gate_c * u, conv_w)
    y_c = jax.nn.silu(z_c) * group_rms_norm(gate_b * conv, g_conv, N_CONV_GROUPS, x.dtype)

    mix = jnp.concatenate([y_m, y_c], axis=-1)
    out = jnp.einsum('bse,ed->bsd', mix, w_out)
    return x + rms_norm(out, g_post)


def setup_inputs(seed: int = 0) -> dict:
    key = jax.random.key(seed)
    ks = jax.random.split(key, 11)
    x = jax.random.normal(ks[0], (BATCH, SEQ, D_MODEL), jnp.float32)
    norm_pre = 1.0 + 0.02 * jax.random.normal(ks[1], (DEPTH, D_MODEL), jnp.float32)
    norm_post = 1.0 + 0.02 * jax.random.normal(ks[2], (DEPTH, D_MODEL), jnp.float32)
    w_in = jax.random.normal(ks[3], (DEPTH, D_MODEL, IN_COLS), jnp.float32) * (D_MODEL ** -0.5)
    b_igate = 0.1 * jax.random.normal(ks[4], (DEPTH, N_MLSTM_HEADS), jnp.float32)
    b_fgate = (jnp.linspace(3.0, 6.0, N_MLSTM_HEADS, dtype=jnp.float32)[None, :]
               + 0.1 * jax.random.normal(ks[5], (DEPTH, N_MLSTM_HEADS), jnp.float32))
    head_norm = 1.0 + 0.02 * jax.random.normal(ks[6], (DEPTH, D_MLSTM), jnp.float32)
    conv_w = jax.random.normal(ks[7], (DEPTH, CONV_WIDTH, D_CONV), jnp.float32) * (CONV_WIDTH ** -0.5)
    conv_norm = 1.0 + 0.02 * jax.random.normal(ks[8], (DEPTH, D_CONV), jnp.float32)
    w_out = jax.random.normal(ks[9], (DEPTH, D_MIX, D_MODEL), jnp.float32) * (D_MIX ** -0.5)
    return {"x": x, "norm_pre": norm_pre, "norm_post": norm_post, "w_in": w_in,
            "b_igate": b_igate, "b_fgate": b_fgate, "head_norm": head_norm,
            "conv_w": conv_w, "conv_norm": conv_norm, "w_out": w_out}


def reference(x, norm_pre, norm_post, w_in, b_igate, b_fgate, head_norm, conv_w, conv_norm, w_out):
    for l in range(DEPTH):
        x = hybrid_layer(x, norm_pre[l], norm_post[l], w_in[l], b_igate[l], b_fgate[l],
                         head_norm[l], conv_w[l], conv_norm[l], w_out[l])
    return x
```

```cpp
#include <hip/hip_runtime.h>
#include <cstdio>
#include <cstdint>
namespace pg8 {
#define PG8_LAS __attribute__((address_space(3)))
typedef unsigned short bf16_t;
typedef short bf16x8 __attribute__((ext_vector_type(8)));
typedef float f32x4 __attribute__((ext_vector_type(4)));
typedef unsigned u32x4 __attribute__((ext_vector_type(4)));
constexpr int BM = 256, BK = 64, HALF = 128, HTB = HALF * BK * 2  , STAGE_BYTES = 8 * HTB, NXCD = 8, WGM = 8;

__host__ __device__ __forceinline__ int lds_byte(int r, int c) { const int st = (r >> 4) * 2 + (c >> 5), rr = r & 15, cc = c & 31, ob = rr * 64 + cc * 2; return st * 1024 + (ob ^ (((ob >> 9) & 1) << 5)); }
__host__ __device__ __forceinline__ void stage_rc(int b, int& R, int& C) { const int st = b / 1024, sb = b % 1024, swz = sb ^ (((sb >> 9) & 1) << 5); R = (st >> 1) * 16 + swz / 64; C = (st & 1) * 32 + (swz % 64) / 2; }
__host__ __device__ __forceinline__ int perm32(int rho) { const int n = rho >> 4, i = rho & 15; return 8 * (i >> 2) + 4 * n + (i & 3); }

struct Unit { int pm, pn; };
struct Gemm { const bf16_t* A; const bf16_t* Bt; int M, N, K; };

struct StaticOrder {
    int nM, nN, nwg, G, c;
    __host__ __device__ void init(int M, int N, int G_, int c_) { nM = M / BM; nN = N / BM; nwg = nM * nN; G = G_; c = c_; }
    __host__ __device__ bool next(int i, Unit& u) const {
        const long L = (long)i * G + c; if (L >= nwg) return false;
        int wgid = (int)L; { const int q = nwg / NXCD, r = nwg % NXCD, xcd = wgid % NXCD, off = wgid / NXCD; wgid = (xcd < r ? xcd * (q + 1) : r * (q + 1) + (xcd - r) * q) + off; }
        const int nig = WGM * nN, gid = wgid / nig, fm = gid * WGM, gsz = (nM - fm) < WGM ? (nM - fm) : WGM;
        u.pm = fm + ((wgid % nig) % gsz); u.pn = (wgid % nig) / gsz; return true;
    }
    __device__ __forceinline__ void a_ready(const Unit&) const {}
    __device__ __forceinline__ void done(const Unit&) const {}
};

__device__ __forceinline__ unsigned cvt_pk_bf16(float lo, float hi) { unsigned r; asm volatile("v_cvt_pk_bf16_f32 %0, %1, %2" : "=v"(r) : "v"(lo), "v"(hi)); return r; }
typedef float f32x2 __attribute__((ext_vector_type(2)));
template <class Epi, class Sched, bool ALIGN_EPI = false, bool SP2 = false>
__device__ __forceinline__ void gemm_phase(PG8_LAS unsigned char* lds, const Gemm g, const Sched& S, const Epi& E) {
    int tid_ = threadIdx.x; asm volatile("" : "+v"(tid_));
    const int tid = tid_, wid = __builtin_amdgcn_readfirstlane(tid >> 6), lane = tid & 63, wr = wid >> 2, wc = wid & 3, fr = lane & 15, fq = lane >> 4;
    const int K = g.K, nt = K / BK;
    unsigned voffA[2], voffB[2];
#pragma unroll
    for (int i = 0; i < 2; ++i) { int R, C; stage_rc(tid * 16 + i * 8192, R, C); const int Rb = Epi::PERM ? ((R & ~31) + perm32(R & 31)) : R;
        voffA[i] = (unsigned)(R * K + C) * 2u; voffB[i] = (unsigned)(Rb * K + C) * 2u; }
    const size_t kstep = (size_t)(BK * 2);
    const size_t hstep = (size_t)HALF * K * 2;
    const size_t tstep = 2 * hstep;
    const unsigned ldsw = (unsigned)wid * 1024u;
    const int aoff = lds_byte(wr * 64 + fr, fq * 8), boff = lds_byte(wc * 32 + fr, fq * 8);
#define PG8_SA(b, h) (((b) * 2 + (h)) * HTB)
#define PG8_SB(b, h) ((4 + (b) * 2 + (h)) * HTB)
#define PG8_STAGE(bufoff, gbase, voff) do { _Pragma("unroll") for (int _i = 0; _i < 2; ++_i) \
        __builtin_amdgcn_global_load_lds((const unsigned*)((const char*)(gbase) + (voff)[_i]), (PG8_LAS unsigned*)(lds + (bufoff) + ldsw + _i * 8192), 16, 0, 0); } while (0)
#define PG8_LDA(dst, b, h) do { _Pragma("unroll") for (int m = 0; m < 4; ++m) _Pragma("unroll") for (int k = 0; k < 2; ++k) dst[m][k] = *(const PG8_LAS bf16x8*)(lds + PG8_SA(b, h) + aoff + m * 2048 + k * 1024); } while (0)
#define PG8_LDB(dst, b, h) do { _Pragma("unroll") for (int n = 0; n < 2; ++n) _Pragma("unroll") for (int k = 0; k < 2; ++k) dst[n][k] = *(const PG8_LAS bf16x8*)(lds + PG8_SB(b, h) + boff + n * 2048 + k * 1024); } while (0)
#define PG8_MMA(ai, bj, At, Bt) do { __builtin_amdgcn_s_setprio(1); _Pragma("unroll") for (int m = 0; m < 4; ++m) _Pragma("unroll") for (int n = 0; n < 2; ++n) _Pragma("unroll") for (int k = 0; k < 2; ++k) \
        acc[ai][bj][m][n] = __builtin_amdgcn_mfma_f32_16x16x32_bf16(Bt[n][k], At[m][k], acc[ai][bj][m][n], 0, 0, 0); __builtin_amdgcn_s_setprio(0); } while (0)
#define PG8_WAIT_V(n) asm volatile("s_waitcnt vmcnt(" #n ")" ::: "memory")
#define PG8_WAIT_L(n) asm volatile("s_waitcnt lgkmcnt(" #n ")" ::: "memory")
#define PG8_BAR __builtin_amdgcn_s_barrier()
#define PG8_SCHED __builtin_amdgcn_sched_barrier(0)
    Unit cur, nxt; int ui = 0;
    if (!S.next(0, cur)) return;
    f32x4 acc[2][2][4][2];
#pragma unroll
    for (int a = 0; a < 2; ++a)
#pragma unroll
        for (int b = 0; b < 2; ++b)
#pragma unroll
            for (int m = 0; m < 4; ++m)
#pragma unroll
                for (int n = 0; n < 2; ++n) acc[a][b][m][n] = (f32x4){0.f, 0.f, 0.f, 0.f};
    bf16x8 At[4][2], B0[2][2], B1[2][2];
    const char* cA = (const char*)g.A + (size_t)cur.pm * tstep; const char* cB = (const char*)g.Bt + (size_t)cur.pn * tstep;
    S.a_ready(cur);
    if constexpr (SP2) {
        PG8_STAGE(PG8_SB(0, 0), cB, voffB); PG8_STAGE(PG8_SB(0, 1), cB + hstep, voffB); PG8_STAGE(PG8_SA(0, 0), cA, voffA); PG8_STAGE(PG8_SA(0, 1), cA + hstep, voffA);
        if (wr == 1) PG8_BAR;
        PG8_WAIT_V(2); PG8_BAR;
        PG8_STAGE(PG8_SB(1, 0), cB + kstep, voffB); PG8_STAGE(PG8_SA(1, 0), cA + kstep, voffA); PG8_STAGE(PG8_SB(1, 1), cB + hstep + kstep, voffB);
        PG8_WAIT_V(6); PG8_BAR;
    } else {
        PG8_STAGE(PG8_SB(0, 0), cB, voffB); PG8_STAGE(PG8_SA(0, 0), cA, voffA); PG8_STAGE(PG8_SB(0, 1), cB + hstep, voffB); PG8_STAGE(PG8_SA(0, 1), cA + hstep, voffA);
        if (wr == 1) PG8_BAR;
        PG8_WAIT_V(4); PG8_BAR;
        PG8_STAGE(PG8_SB(1, 0), cB + kstep, voffB); PG8_STAGE(PG8_SA(1, 0), cA + kstep, voffA); PG8_STAGE(PG8_SB(1, 1), cB + hstep + kstep, voffB);
        PG8_WAIT_V(6); PG8_BAR;
    }
    for (;;) {
        const bool has_next = S.next(ui + 1, nxt);
        const char* nA = has_next ? (const char*)g.A + (size_t)nxt.pm * tstep : cA; const char* nB = has_next ? (const char*)g.Bt + (size_t)nxt.pn * tstep : cB;
        for (int t = 0; t < nt; t += 2) {
            const bool last = (t == nt - 2);
            const char* a1 = cA + (size_t)(t + 1) * kstep;
            const char* a2 = last ? nA : cA + (size_t)(t + 2) * kstep; const char* b2 = last ? nB : cB + (size_t)(t + 2) * kstep;
            const char* a3 = a2 + kstep; const char* b3 = b2 + kstep;
            if (last && has_next) S.a_ready(nxt);
            if constexpr (SP2) {
            PG8_LDB(B0, 0, 0); PG8_LDB(B1, 0, 1); PG8_SCHED; PG8_LDA(At, 0, 0); PG8_STAGE(PG8_SA(1, 1), a1 + hstep, voffA);
            PG8_WAIT_V(8); PG8_WAIT_L(0); PG8_BAR; PG8_MMA(0, 0, At, B0); PG8_MMA(0, 1, At, B1); PG8_BAR; PG8_SCHED;
            PG8_LDA(At, 0, 1); PG8_STAGE(PG8_SB(0, 0), b2, voffB); PG8_STAGE(PG8_SB(0, 1), b2 + hstep, voffB); PG8_STAGE(PG8_SA(0, 0), a2, voffA);
            PG8_WAIT_V(8); PG8_WAIT_L(0); PG8_BAR; PG8_MMA(1, 0, At, B0); PG8_MMA(1, 1, At, B1); PG8_BAR; PG8_SCHED;
            PG8_LDB(B0, 1, 0); PG8_LDB(B1, 1, 1); PG8_SCHED; PG8_LDA(At, 1, 0); PG8_STAGE(PG8_SA(0, 1), a2 + hstep, voffA);
            PG8_WAIT_V(8); PG8_WAIT_L(0); PG8_BAR; PG8_MMA(0, 0, At, B0); PG8_MMA(0, 1, At, B1); PG8_BAR; PG8_SCHED;
            PG8_LDA(At, 1, 1); PG8_STAGE(PG8_SB(1, 0), b3, voffB); PG8_STAGE(PG8_SB(1, 1), b3 + hstep, voffB); PG8_STAGE(PG8_SA(1, 0), a3, voffA);
            PG8_WAIT_V(8); PG8_WAIT_L(0); PG8_BAR; PG8_MMA(1, 0, At, B0); PG8_MMA(1, 1, At, B1); PG8_BAR; PG8_SCHED;
            } else {
            PG8_LDB(B0, 0, 0); PG8_SCHED; PG8_LDA(At, 0, 0); PG8_STAGE(PG8_SA(1, 1), a1 + hstep, voffA);
            PG8_WAIT_L(8); PG8_BAR; PG8_WAIT_L(0); PG8_MMA(0, 0, At, B0); PG8_BAR; PG8_SCHED;
            PG8_LDB(B1, 0, 1); PG8_STAGE(PG8_SB(0, 0), b2, voffB);
            PG8_BAR; PG8_WAIT_L(0); PG8_MMA(0, 1, At, B1); PG8_BAR;
            PG8_LDA(At, 0, 1); PG8_STAGE(PG8_SA(0, 0), a2, voffA);
            PG8_BAR; PG8_WAIT_L(0); PG8_MMA(1, 0, At, B0); PG8_BAR; PG8_SCHED;
            PG8_STAGE(PG8_SB(0, 1), b2 + hstep, voffB);
            PG8_WAIT_V(6); PG8_BAR; PG8_MMA(1, 1, At, B1); PG8_BAR;
            PG8_LDB(B0, 1, 0); PG8_SCHED; PG8_LDA(At, 1, 0); PG8_STAGE(PG8_SA(0, 1), a2 + hstep, voffA);
            PG8_WAIT_L(8); PG8_BAR; PG8_WAIT_L(0); PG8_MMA(0, 0, At, B0); PG8_BAR; PG8_SCHED;
            PG8_LDB(B1, 1, 1); PG8_STAGE(PG8_SB(1, 0), b3, voffB);
            PG8_BAR; PG8_WAIT_L(0); PG8_MMA(0, 1, At, B1); PG8_BAR;
            PG8_LDA(At, 1, 1); PG8_STAGE(PG8_SA(1, 0), a3, voffA);
            PG8_BAR; PG8_WAIT_L(0); PG8_MMA(1, 0, At, B0); PG8_BAR; PG8_SCHED;
            PG8_STAGE(PG8_SB(1, 1), b3 + hstep, voffB);
            PG8_WAIT_V(6); PG8_BAR; PG8_MMA(1, 1, At, B1); PG8_BAR;
            }
        }
        if constexpr (ALIGN_EPI) { if (wr == 0) PG8_BAR; }
        if constexpr (!Epi::AFTER_DRAIN) { E(acc, cur, wr, wc, fr, fq); S.done(cur); }
        if (!has_next) break;
#pragma unroll
        for (int a = 0; a < 2; ++a)
#pragma unroll
            for (int b = 0; b < 2; ++b)
#pragma unroll
                for (int m = 0; m < 4; ++m)
#pragma unroll
                    for (int n = 0; n < 2; ++n) acc[a][b][m][n] = (f32x4){0.f, 0.f, 0.f, 0.f};
        cur = nxt; cA = nA; cB = nB; ++ui;
        if constexpr (ALIGN_EPI) { if (wr == 1) PG8_BAR; }
    }
    PG8_WAIT_V(0);
    if constexpr (!ALIGN_EPI) { if (wr == 0) PG8_BAR; }
    PG8_BAR;
    if constexpr (Epi::AFTER_DRAIN) { E.fused(acc, cur, wr, wc, fr, fq, lds, wid, lane); S.done(cur); }
#undef PG8_SA
#undef PG8_SB
#undef PG8_STAGE
#undef PG8_LDA
#undef PG8_LDB
#undef PG8_MMA
#undef PG8_WAIT_V
#undef PG8_WAIT_L
#undef PG8_BAR
#undef PG8_SCHED
}
}

constexpr int D = 1024, BATCH = 16, SEQ = 4096, DEPTH = 4, MTOK = BATCH * SEQ;
constexpr int NH = 4, DV = 256, DQK = 128, INCOLS = 8200, N1 = 8192, DMIX = 2048, DCONV = 1024;
constexpr int CHUNK = 64, NCH = SEQ / CHUNK, NSEG = 4, CPS = NCH / NSEG;
constexpr int NUNIT = BATCH * NH * NSEG;
constexpr float EPS = 1e-6f;
constexpr int NWAVES = 8;

constexpr size_t MiB = 1u << 20;
constexpr size_t WS_CTL = 0, CTL_ZERO_BYTES = 1 * MiB;
constexpr size_t WS_BT1 = 2 * MiB;
constexpr size_t WS_BT2 = 66 * MiB;
constexpr size_t WS_WG = 82 * MiB;
constexpr size_t WS_RSTD = 83 * MiB;
constexpr size_t WS_LI = 84 * MiB;
constexpr size_t WS_LF = 85 * MiB;
constexpr size_t WS_FIX = 86 * MiB;
constexpr size_t FIX_ARR = 256 * 2 * 1024;
constexpr size_t WS_SEGC = 94 * MiB;
constexpr size_t WS_SEGN = 126 * MiB;
constexpr size_t WS_SEGS = 127 * MiB;
constexpr size_t WS_XB = 128 * MiB;
constexpr size_t WS_QKV = 256 * MiB;
constexpr size_t WS_MIX = 512 * MiB;
constexpr size_t WS_OUT = 768 * MiB;
constexpr size_t WS_END = 896 * MiB;
constexpr size_t WS_DBG = 896 * MiB;
constexpr int CW_BAR = 4096;

constexpr int RING_BYTES = 131072;
constexpr int EPI_OFF = RING_BYTES;
constexpr int MISC_OFF = RING_BYTES + 8192;
constexpr int LDS_BYTES = 147456;

#define GAS __attribute__((address_space(1)))
#define LAS __attribute__((address_space(3)))
typedef unsigned short bf16;
typedef unsigned v4u __attribute__((ext_vector_type(4)));
typedef unsigned v2u __attribute__((ext_vector_type(2)));
typedef float f32x4 __attribute__((ext_vector_type(4)));
typedef short bf16x8 __attribute__((ext_vector_type(8)));
typedef short s16x4 __attribute__((ext_vector_type(4)));
#define LDS_WAIT() asm volatile("s_waitcnt lgkmcnt(0)" ::: "memory")
#define VM_WAIT() asm volatile("s_waitcnt vmcnt(0)" ::: "memory")
using pg8::cvt_pk_bf16;
__device__ __forceinline__ float bf_lo(unsigned u) { return __builtin_bit_cast(float, u << 16); }
__device__ __forceinline__ float bf_hi(unsigned u) { return __builtin_bit_cast(float, u & 0xffff0000u); }
__device__ __forceinline__ float dpp_ror1(float v) { return __int_as_float(__builtin_amdgcn_update_dpp(0, __float_as_int(v), 0x121, 0xf, 0xf, false)); }
__device__ __forceinline__ float dpp_ror2(float v) { return __int_as_float(__builtin_amdgcn_update_dpp(0, __float_as_int(v), 0x122, 0xf, 0xf, false)); }
__device__ __forceinline__ float sigmoidf_(float x) { return 1.0f / (1.0f + __expf(-x)); }
__device__ __forceinline__ float wave_sum(float v) {
#pragma unroll
    for (int o = 1; o < 64; o <<= 1) v += __shfl_xor(v, o);
    return v;
}

#define XB_TMO      128
#define XB_XCNT(j)  (256  + 64 * (j))
#define XB_XSUB(j)  (1280 + 64 * (j))
#define XB_XGEN(j)  (2304 + 64 * (j))
#define XB_TOP      3328
#define XB_TOPGEN   3392
#define XCD_BAR_WORDS 3456
#define XB_SPIN_CAP (1u << 18)
__device__ __forceinline__ unsigned xb_ld(unsigned* p)              { return __hip_atomic_load(p, __ATOMIC_RELAXED, __HIP_MEMORY_SCOPE_AGENT); }
__device__ __forceinline__ unsigned xb_add(unsigned* p, unsigned v) { return __hip_atomic_fetch_add(p, v, __ATOMIC_RELAXED, __HIP_MEMORY_SCOPE_AGENT); }
__device__ __forceinline__ unsigned xb_xcc_id() { return (unsigned)__builtin_amdgcn_s_getreg((3 << 11) | 20) & 0xFu; }
#define XB_SPIN(cond, bar) do { unsigned _sp = 0; while (cond) { __builtin_amdgcn_s_sleep(1); \
    if ((++_sp & 255u) == 0u) { if (xb_ld(&(bar)[XB_TMO])) break; if (_sp > XB_SPIN_CAP) { atomicAdd(&(bar)[XB_TMO], 1u); break; } } } } while (0)
struct XcdBarrier { unsigned* bar; unsigned x; volatile LAS unsigned* st; };
__device__ __forceinline__ XcdBarrier xcd_barrier_post(unsigned* bar, volatile LAS unsigned* st) {
    XcdBarrier b; b.bar = bar; b.x = xb_xcc_id(); b.st = st;
    if (threadIdx.x == 0) (void)xb_add(&bar[XB_XCNT(b.x)], 1u);
    return b;
}
__device__ __forceinline__ void xcd_barrier_complete(unsigned* bar, unsigned x, unsigned& nloc, unsigned& nx) {
    const unsigned G = gridDim.x * gridDim.y * gridDim.z;
    unsigned sum, cnt, mine, sp = 0u;
    for (;;) {
        sum = 0u; cnt = 0u; mine = 0u;
#pragma unroll
        for (unsigned j = 0; j < 16; ++j) { const unsigned c = xb_ld(&bar[XB_XCNT(j)]); sum += c; cnt += (c > 0u) ? 1u : 0u; mine = (j == x) ? c : mine; }
        if (sum == G) break;
        __builtin_amdgcn_s_sleep(1);
        if ((++sp & 255u) == 0u) { if (xb_ld(&bar[XB_TMO])) break; if (sp > XB_SPIN_CAP) { atomicAdd(&bar[XB_TMO], 1u); break; } }
    }
    nloc = mine > 0u ? mine : 1u; nx = cnt > 0u ? cnt : 1u;
}
__device__ __forceinline__ void xcd_barrier(const XcdBarrier& b) {
    asm volatile("s_waitcnt vmcnt(0)" ::: "memory");
    __syncthreads();
    if (threadIdx.x == 0) {
        unsigned* bar = b.bar; const unsigned bx = xb_xcc_id();
        __builtin_amdgcn_s_waitcnt(0);
        unsigned nloc = b.st[0], nx = b.st[1];
        if (nloc == 0u) { xcd_barrier_complete(bar, bx, nloc, nx); b.st[0] = nloc; b.st[1] = nx; }
        const unsigned old = xb_add(&bar[XB_XSUB(bx)], 1u);
        const unsigned gen = old / nloc;
        if (old + 1u == (gen + 1u) * nloc) {
            __builtin_amdgcn_fence(__ATOMIC_RELEASE, "agent");
            asm volatile("s_waitcnt vmcnt(0)" ::: "memory");
            const unsigned og = xb_add(&bar[XB_TOP], 1u);
            const unsigned tg = og / nx;
            if (og + 1u == (tg + 1u) * nx) xb_add(&bar[XB_TOPGEN], 1u);
            else XB_SPIN(xb_ld(&bar[XB_TOPGEN]) == tg, bar);
            __builtin_amdgcn_fence(__ATOMIC_ACQUIRE, "agent");
            xb_add(&bar[XB_XGEN(bx)], 1u);
            asm volatile("s_waitcnt vmcnt(0)" ::: "memory");
        } else {
            XB_SPIN(xb_ld(&bar[XB_XGEN(bx)]) == gen, bar);
            __builtin_amdgcn_fence(__ATOMIC_ACQUIRE, "agent");
            asm volatile("s_waitcnt vmcnt(0)" ::: "memory");
        }
    }
    __syncthreads();
}

struct Frame {
    LAS unsigned char* lds;
    int tid, lane, wave, vcu, G;
    const float *x, *norm_pre, *norm_post, *w_in, *b_i, *b_f, *head_norm, *conv_w, *conv_norm, *w_out;
    float* out;
    unsigned char* ws;
};

__host__ __device__ __forceinline__ int rho_plain(int ci) {
    const int wc = ci >> 6, fq = (ci >> 4) & 3, bj = (ci >> 3) & 1, n = (ci >> 2) & 1, e = ci & 3;
    return 128 * bj + 32 * wc + 16 * n + 4 * fq + e;
}
__host__ __device__ __forceinline__ int dest1(int cc) {
    if (cc < 2048) return (cc & ~255) + rho_plain(cc & 255);
    if (cc < 4096) { const int qn = (cc - 2048) >> 10, ch = cc & 1023, gt = ch >> 7, c = ch & 127;
        const int wc = c >> 5, fq = (c >> 3) & 3, bj = (c >> 2) & 1, e = c & 3;
        return 256 * (8 + gt) + 128 * bj + 32 * wc + 16 * qn + 4 * fq + e; }
    { const int qn = (cc - 4096) >> 10, ch = cc & 1023, g = ch >> 6, c = ch & 63;
      const int wc = c >> 4, fq = (c >> 2) & 3, e = c & 3, bj = qn >> 1, n = qn & 1;
      return 256 * (16 + g) + 128 * bj + 32 * wc + 16 * n + 4 * fq + e; }
}

template <int WHICH>
__device__ __forceinline__ void transpose_item(const float* W, int ldw, int k0, int srccol0, int cc0, const float* gk, float cscale, bf16* WT, int Kd, LAS float* scr, int lane) {
#pragma unroll 8
    for (int i = 0; i < 32; ++i) { const int kk = 2 * i + (lane >> 5);
        float v = W[(size_t)(k0 + kk) * ldw + srccol0 + (lane & 31)];
        if (WHICH == 0) v *= gk[k0 + kk] * cscale;
        scr[kk * 33 + (lane & 31)] = v; }
    LDS_WAIT(); asm volatile("" ::: "memory");
    const int c = lane & 7;
#pragma unroll
    for (int j = 0; j < 4; ++j) { const int n = (lane >> 3) + 8 * j; const LAS float* s = scr + (8 * c) * 33 + n;
        v4u o; o.x = cvt_pk_bf16(s[0 * 33], s[1 * 33]); o.y = cvt_pk_bf16(s[2 * 33], s[3 * 33]); o.z = cvt_pk_bf16(s[4 * 33], s[5 * 33]); o.w = cvt_pk_bf16(s[6 * 33], s[7 * 33]);
        const int cc = cc0 + n; const int row = (WHICH == 0) ? dest1(cc) : ((cc & ~255) + rho_plain(cc & 255));
        *(GAS v4u*)(WT + (size_t)row * Kd + k0 + 8 * c) = o; }
    LDS_WAIT(); asm volatile("" ::: "memory");
}
__device__ __forceinline__ void prep_phase(Frame& F) {
    LAS float* scr = (LAS float*)(F.lds + F.wave * 16384);
    const int gw = F.vcu * NWAVES + F.wave, NGW = F.G * NWAVES;
    constexpr int I1 = 16 * 256, I2 = 32 * 32;
    for (int it = gw; it < DEPTH * (I1 + I2); it += NGW) {
        const int l = it / (I1 + I2); int r = it % (I1 + I2);
        if (r < I1) { const int kb = r >> 8, cb = r & 255, cc0 = cb * 32, src = cc0 < 4096 ? cc0 : cc0 + 8;
            transpose_item<0>(F.w_in + (size_t)l * D * INCOLS, INCOLS, kb * 64, src, cc0, F.norm_pre + l * D, cc0 < 512 ? 0.08838834764831845f : 1.0f,
                              (bf16*)(F.ws + WS_BT1) + (size_t)l * N1 * D, D, scr, F.lane);
        } else { r -= I1; const int kb = r >> 5, cb = r & 31;
            transpose_item<1>(F.w_out + (size_t)l * DMIX * D, D, kb * 64, cb * 32, cb * 32, nullptr, 1.0f, (bf16*)(F.ws + WS_BT2) + (size_t)l * D * DMIX, DMIX, scr, F.lane); }
    }
    float* wg = (float*)(F.ws + WS_WG);
    for (int i = (F.vcu * NWAVES + F.wave) * 64 + F.lane; i < DEPTH * 8 * D; i += F.G * NWAVES * 64) {
        const int l = i / (8 * D), j = (i / D) & 7, k = i % D;
        wg[i] = F.w_in[(size_t)l * D * INCOLS + (size_t)k * INCOLS + 4096 + j] * F.norm_pre[l * D + k];
    }
}

__device__ __forceinline__ void thin_phase(Frame& F, const int l, const bool wn) {
    const int gw = F.vcu * NWAVES + F.wave, NGW = F.G * NWAVES, lane = F.lane;
    const float* xsrc = (l <= 1) ? F.x : F.out;
    const bf16* OUTB = (const bf16*)(F.ws + WS_OUT);
    bf16* XB = (bf16*)(F.ws + WS_XB);
    float* RSTD = (float*)(F.ws + WS_RSTD);
    float* LI = (float*)(F.ws + WS_LI); float* LF = (float*)(F.ws + WS_LF);
    f32x4 wg[8][4];
    if (wn) {
        const float* wgp = (const float*)(F.ws + WS_WG) + (size_t)l * 8 * D;
#pragma unroll
        for (int j = 0; j < 8; ++j)
#pragma unroll
            for (int q = 0; q < 4; ++q) wg[j][q] = *(const GAS f32x4*)(wgp + j * D + 256 * q + 4 * lane);
    }
    f32x4 gp[4];
    if (l > 0) {
#pragma unroll
        for (int q = 0; q < 4; ++q) gp[q] = *(const GAS f32x4*)(F.norm_post + (l - 1) * D + 256 * q + 4 * lane);
    }
    float bias = 0.f;
    if (wn) bias = (lane < 4) ? F.b_i[l * NH + lane] : (lane < 8 ? F.b_f[l * NH + lane - 4] : 0.f);
    for (int m = gw; m < MTOK; m += NGW) {
        f32x4 v[4];
#pragma unroll
        for (int q = 0; q < 4; ++q) v[q] = *(const GAS f32x4*)(xsrc + (size_t)m * D + 256 * q + 4 * lane);
        if (l > 0) {
            f32x4 o[4]; float ss = 0.f;
#pragma unroll
            for (int q = 0; q < 4; ++q) { const v2u w = *(const GAS v2u*)(OUTB + (size_t)m * D + 256 * q + 4 * lane);
                o[q] = (f32x4){bf_lo(w.x), bf_hi(w.x), bf_lo(w.y), bf_hi(w.y)}; ss += (o[q].x * o[q].x + o[q].y * o[q].y) + (o[q].z * o[q].z + o[q].w * o[q].w); }
            const float rs = rsqrtf(wave_sum(ss) * (1.0f / D) + EPS);
#pragma unroll
            for (int q = 0; q < 4; ++q) { v[q] = v[q] + o[q] * rs * gp[q]; *(GAS f32x4*)(F.out + (size_t)m * D + 256 * q + 4 * lane) = v[q]; }
        }
        if (wn) {
            float ss = 0.f;
#pragma unroll
            for (int q = 0; q < 4; ++q) ss += (v[q].x * v[q].x + v[q].y * v[q].y) + (v[q].z * v[q].z + v[q].w * v[q].w);
            const float rstd = rsqrtf(wave_sum(ss) * (1.0f / D) + EPS);
#pragma unroll
            for (int q = 0; q < 4; ++q) { v2u w; w.x = cvt_pk_bf16(v[q].x, v[q].y); w.y = cvt_pk_bf16(v[q].z, v[q].w); *(GAS v2u*)(XB + (size_t)m * D + 256 * q + 4 * lane) = w; }
            float pre = 0.f;
#pragma unroll
            for (int j = 0; j < 8; ++j) { float a = 0.f;
#pragma unroll
                for (int q = 0; q < 4; ++q) a += (v[q].x * wg[j][q].x + v[q].y * wg[j][q].y) + (v[q].z * wg[j][q].z + v[q].w * wg[j][q].w);
                a = wave_sum(a); pre = (lane == j) ? a : pre; }
            if (lane == 0) RSTD[m] = rstd;
            const float xg = pre * rstd + bias;
            const int b = m >> 12, t = m & (SEQ - 1);
            if (lane < 4) LI[(size_t)(b * NH + lane) * SEQ + t] = xg;
            else if (lane < 8) { const float ls = fminf(xg, 0.f) - __logf(1.0f + __expf(-fabsf(xg))); LF[(size_t)(b * NH + lane - 4) * SEQ + t] = ls; }
        }
    }
}

struct Epi1 {
    static constexpr bool PERM = false, AFTER_DRAIN = false;
    bf16* QKV; bf16* MIX; const float* RSTD; const float* convw; const float* convg; float* fix; LAS unsigned char* elds; bf16* DBGG;
    __device__ __forceinline__ void operator()(pg8::f32x4 (&acc)[2][2][4][2], const pg8::Unit& u, int wr, int wc, int fr, int fq) const {
        asm volatile("" : "+v"(fr), "+v"(fq));
        const int row0 = u.pm * 256 + wr * 64 + fr;
        if (u.pn < 8) {
#pragma unroll
            for (int ai = 0; ai < 2; ++ai)
#pragma unroll
                for (int m = 0; m < 4; ++m) { const int r = row0 + ai * 128 + m * 16; const float rs = RSTD[r];
                    bf16* rowp = QKV + (size_t)r * 2048 + u.pn * 256 + 64 * wc + 16 * fq;
#pragma unroll
                    for (int bj = 0; bj < 2; ++bj) { const f32x4 v0 = acc[ai][bj][m][0] * rs, v1 = acc[ai][bj][m][1] * rs;
                        v4u w; w.x = cvt_pk_bf16(v0[0], v0[1]); w.y = cvt_pk_bf16(v0[2], v0[3]); w.z = cvt_pk_bf16(v1[0], v1[1]); w.w = cvt_pk_bf16(v1[2], v1[3]);
                        *(GAS v4u*)(rowp + 8 * bj) = w; } }
        } else if (u.pn < 16) {
#pragma unroll
            for (int ai = 0; ai < 2; ++ai)
#pragma unroll
                for (int m = 0; m < 4; ++m) { const int r = row0 + ai * 128 + m * 16; const float rs = RSTD[r];
                    float g[8];
#pragma unroll
                    for (int bj = 0; bj < 2; ++bj)
#pragma unroll
                        for (int e = 0; e < 4; ++e) { const float o = acc[ai][bj][m][0][e] * rs, z = acc[ai][bj][m][1][e] * rs; g[4 * bj + e] = z * sigmoidf_(z) * sigmoidf_(o); }
                    v4u w; w.x = cvt_pk_bf16(g[0], g[1]); w.y = cvt_pk_bf16(g[2], g[3]); w.z = cvt_pk_bf16(g[4], g[5]); w.w = cvt_pk_bf16(g[6], g[7]);
                    *(GAS v4u*)(MIX + (size_t)r * 2048 + (u.pn - 8) * 128 + 32 * wc + 8 * fq) = w;
#ifdef DBG
                    *(GAS v4u*)(DBGG + (size_t)r * 1024 + (u.pn - 8) * 128 + 32 * wc + 8 * fq) = w;
#endif
                    }
        } else {
            const int g = u.pn - 16, ch0 = 64 * g + 16 * wc + 4 * fq;
            LAS float* halo = (LAS float*)elds;
            LAS float* part = (LAS float*)(elds + 2048);
            float* cuL = fix; float* cuF = fix + FIX_ARR; float* bF = fix + 2 * FIX_ARR; float* zF = fix + 3 * FIX_ARR;
#pragma unroll
            for (int ai = 0; ai < 2; ++ai)
#pragma unroll
                for (int m = 0; m < 4; ++m) { const float rs = RSTD[row0 + ai * 128 + m * 16];
                    acc[ai][0][m][0] = acc[ai][0][m][0] * acc[ai][1][m][0] * (rs * rs); acc[ai][0][m][1] = acc[ai][0][m][1] * rs; acc[ai][1][m][1] = acc[ai][1][m][1] * rs; }
#pragma unroll
            for (int ai = 0; ai < 2; ++ai) {
                if (fr >= 14) { *(LAS f32x4*)(halo + ((2 * ai + wr) * 2 + (fr - 14)) * 64 + 16 * wc + 4 * fq) = acc[ai][0][3][0];
                    if (ai == 1 && wr == 1) *(GAS f32x4*)(cuL + ((size_t)u.pm * 2 + (fr - 14)) * 1024 + ch0) = acc[1][0][3][0]; }
            }
            if (wr == 0 && fr < 2) { const size_t o = ((size_t)u.pm * 2 + fr) * 1024 + ch0;
                *(GAS f32x4*)(cuF + o) = acc[0][0][0][0]; *(GAS f32x4*)(bF + o) = acc[0][0][0][1]; *(GAS f32x4*)(zF + o) = acc[0][1][0][1]; }
            LDS_WAIT(); __builtin_amdgcn_s_barrier(); asm volatile("" ::: "memory");
            f32x4 w0 = *(const GAS f32x4*)(convw + ch0), w1 = *(const GAS f32x4*)(convw + 1024 + ch0), w2 = *(const GAS f32x4*)(convw + 2048 + ch0);
#pragma unroll
            for (int ai = 0; ai < 2; ++ai) {
                const int blk = 2 * ai + wr;
                f32x4 p1 = (f32x4){0.f, 0.f, 0.f, 0.f}, p2 = p1;
                if (blk > 0) { p1 = *(const LAS f32x4*)(halo + ((blk - 1) * 2 + 1) * 64 + 16 * wc + 4 * fq); p2 = *(const LAS f32x4*)(halo + ((blk - 1) * 2 + (fr & 1)) * 64 + 16 * wc + 4 * fq); }
#pragma unroll
                for (int m = 0; m < 4; ++m) {
                    const f32x4 cu = acc[ai][0][m][0]; f32x4 s1, s2;
#pragma unroll
                    for (int e = 0; e < 4; ++e) { s1[e] = dpp_ror1(cu[e]); s2[e] = dpp_ror2(cu[e]); }
                    const f32x4 a1 = (fr >= 1) ? s1 : p1, a2 = (fr >= 2) ? s2 : p2;
                    const f32x4 cv = w2 * cu + w1 * a1 + w0 * a2;
                    const f32x4 bc = acc[ai][0][m][1] * cv;
                    acc[ai][1][m][0] = bc;
                    float ss = (bc[0] * bc[0] + bc[1] * bc[1]) + (bc[2] * bc[2] + bc[3] * bc[3]);
                    ss += __shfl_xor(ss, 16); ss += __shfl_xor(ss, 32);
                    if (fq == 0) part[(128 * ai + 64 * wr + 16 * m + fr) * 4 + wc] = ss;
                    p1 = s1; p2 = s2;
                }
            }
            LDS_WAIT(); __builtin_amdgcn_s_barrier(); asm volatile("" ::: "memory");
            const f32x4 gc = *(const GAS f32x4*)(convg + ch0);
#pragma unroll
            for (int ai = 0; ai < 2; ++ai)
#pragma unroll
                for (int m = 0; m < 4; ++m) { const int rt = 128 * ai + 64 * wr + 16 * m + fr;
                    const f32x4 ps = *(const LAS f32x4*)(part + rt * 4);
                    const float rg = rsqrtf(((ps[0] + ps[1]) + (ps[2] + ps[3])) * (1.0f / 64.0f) + EPS);
                    const f32x4 z = acc[ai][1][m][1], bc = acc[ai][1][m][0]; f32x4 y;
#pragma unroll
                    for (int e = 0; e < 4; ++e) y[e] = z[e] * sigmoidf_(z[e]) * bc[e] * rg * gc[e];
                    v2u w; w.x = cvt_pk_bf16(y[0], y[1]); w.y = cvt_pk_bf16(y[2], y[3]);
                    *(GAS v2u*)(MIX + (size_t)(u.pm * 256 + rt) * 2048 + 1024 + ch0) = w; }
        }
    }
};
struct Epi2 {
    static constexpr bool PERM = false, AFTER_DRAIN = false;
    bf16* O;
    __device__ __forceinline__ void operator()(pg8::f32x4 (&acc)[2][2][4][2], const pg8::Unit& u, int wr, int wc, int fr, int fq) const {
        const int row0 = u.pm * 256 + wr * 64 + fr;
#pragma unroll
        for (int ai = 0; ai < 2; ++ai)
#pragma unroll
            for (int m = 0; m < 4; ++m) { bf16* rowp = O + (size_t)(row0 + ai * 128 + m * 16) * 1024 + u.pn * 256 + 64 * wc + 16 * fq;
#pragma unroll
                for (int bj = 0; bj < 2; ++bj) { const f32x4 v0 = acc[ai][bj][m][0], v1 = acc[ai][bj][m][1];
                    v4u w; w.x = cvt_pk_bf16(v0[0], v0[1]); w.y = cvt_pk_bf16(v0[2], v0[3]); w.z = cvt_pk_bf16(v1[0], v1[1]); w.w = cvt_pk_bf16(v1[2], v1[3]);
                    *(GAS v4u*)(rowp + 8 * bj) = w; } }
    }
};

__device__ __forceinline__ void conv_fixup(Frame& F, const int l) {
    const float* fix = (const float*)(F.ws + WS_FIX);
    const float *cuL = fix, *cuF = fix + FIX_ARR, *bF = fix + 2 * FIX_ARR, *zF = fix + 3 * FIX_ARR;
    const float* cw = F.conv_w + (size_t)l * 3 * DCONV; const float* cg = F.conv_norm + (size_t)l * DCONV;
    bf16* MIX = (bf16*)(F.ws + WS_MIX);
    const int gw = F.vcu * NWAVES + F.wave, NGW = F.G * NWAVES, lane = F.lane;
    for (int it = gw; it < 256 * 2 * 16; it += NGW) {
        const int pm = it >> 5, rr = (it >> 4) & 1, g = it & 15;
        if ((pm & 15) == 0) continue;
        const int ch = 64 * g + lane;
        const float c0 = cuF[((size_t)pm * 2 + 0) * 1024 + ch], c1 = cuF[((size_t)pm * 2 + 1) * 1024 + ch];
        const float pl0 = cuL[((size_t)(pm - 1) * 2 + 0) * 1024 + ch], pl1 = cuL[((size_t)(pm - 1) * 2 + 1) * 1024 + ch];
        const float w0 = cw[ch], w1 = cw[1024 + ch], w2 = cw[2048 + ch];
        const float cv = rr == 0 ? (w2 * c0 + w1 * pl1 + w0 * pl0) : (w2 * c1 + w1 * c0 + w0 * pl1);
        const float bc = bF[((size_t)pm * 2 + rr) * 1024 + ch] * cv;
        const float rg = rsqrtf(wave_sum(bc * bc) * (1.0f / 64.0f) + EPS);
        const float z = zF[((size_t)pm * 2 + rr) * 1024 + ch];
        const float y = z * sigmoidf_(z) * bc * rg * cg[ch];
        MIX[(size_t)(pm * 256 + rr) * 2048 + 1024 + ch] = (bf16)(cvt_pk_bf16(y, y) & 0xffffu);
    }
}

namespace ml {
constexpr int L_Q = 0, L_K = 16384, L_V = 32768, L_P = 65536, L_SC = 73728;
constexpr int SP = 0, SR = 64, SIW = 128, SEI = 192, SW = 256, RSP = 320, QN = 448, HN = 512, NV = 1024, MISC = 1152;
__device__ __forceinline__ unsigned off_b(unsigned row, unsigned ch) { return 256u * row + 16u * (ch ^ (((row & 3) << 2) | ((row >> 2) & 3))); }
__device__ __forceinline__ unsigned tr_addr16(unsigned lane, unsigned c, unsigned ks, unsigned t) {
    const unsigned g = lane >> 4, q = (lane & 15) >> 2, p = lane & 3;
    return off_b(32 * ks + 8 * g + 4 * t + q, 2 * c + (p >> 1)) + 8 * (p & 1);
}
__device__ __forceinline__ s16x4 tr_read(const LAS unsigned char* p) { return __builtin_bit_cast(s16x4, __builtin_amdgcn_ds_read_tr16_b64_v4i16((LAS s16x4*)p)); }
__device__ __forceinline__ bf16x8 cat8(s16x4 a, s16x4 b) { return (bf16x8){a[0], a[1], a[2], a[3], b[0], b[1], b[2], b[3]}; }
__device__ __forceinline__ bf16x8 pack8(const f32x4 a, const f32x4 b) {
    const unsigned x = cvt_pk_bf16(a[0], a[1]), y = cvt_pk_bf16(a[2], a[3]), z = cvt_pk_bf16(b[0], b[1]), w = cvt_pk_bf16(b[2], b[3]);
    return __builtin_bit_cast(bf16x8, (v4u){x, y, z, w});
}
__device__ __forceinline__ bf16x8 scale8(const bf16x8 v, const f32x4 s0, const f32x4 s1) {
    const v4u u = __builtin_bit_cast(v4u, v);
    const unsigned x = cvt_pk_bf16(bf_lo(u.x) * s0[0], bf_hi(u.x) * s0[1]), y = cvt_pk_bf16(bf_lo(u.y) * s0[2], bf_hi(u.y) * s0[3]);
    const unsigned z = cvt_pk_bf16(bf_lo(u.z) * s1[0], bf_hi(u.z) * s1[1]), w = cvt_pk_bf16(bf_lo(u.w) * s1[2], bf_hi(u.w) * s1[3]);
    return __builtin_bit_cast(bf16x8, (v4u){x, y, z, w});
}
#define MFMA16(a, b, c) __builtin_amdgcn_mfma_f32_16x16x32_bf16(a, b, c, 0, 0, 0)

__device__ __forceinline__ float chunk_scalars(LAS float* sc, float lf, float li, float m, int lane, float& sum_bL) {
    float b = lf;
#pragma unroll
    for (int o = 1; o < 64; o <<= 1) { const float t = __shfl_up(b, o); if (lane >= o) b += t; }
    const float bL = __shfl(b, 63);
    const float p = li - b;
    float cm = p;
#pragma unroll
    for (int o = 1; o < 64; o <<= 1) { const float t = __shfl_up(cm, o); if (lane >= o) cm = fmaxf(cm, t); }
    const float cmL = __shfl(cm, 63);
    const float mm = fmaxf(m, cm), mc = b + mm;
    const float mnew = fmaxf(bL + m, bL + cmL);
    sc[SP + lane] = p; sc[SR + lane] = -mm; sc[SIW + lane] = __expf(m - mm); sc[SEI + lane] = __expf(-mc); sc[SW + lane] = __expf(bL + p - mnew);
    if (lane == 0) sc[MISC] = __expf(bL + m - mnew);
    sum_bL += bL;
    return mnew;
}

struct Stage { v4u q[2], k[2], v[4]; float lf, li; };
template <bool PASSC>
__device__ __forceinline__ void stage_load(Stage& s, const bf16* QKV, const float* LF, const float* LI, size_t rowbase, int h, size_t gbase, int tid) {
#pragma unroll
    for (int i = 0; i < 2; ++i) { const int idx = tid + 512 * i, row = idx >> 4, ch = idx & 15;
        if (PASSC) s.q[i] = *(const GAS v4u*)(QKV + (rowbase + row) * 2048 + h * 128 + 8 * ch);
        s.k[i] = *(const GAS v4u*)(QKV + (rowbase + row) * 2048 + 512 + h * 128 + 8 * ch); }
#pragma unroll
    for (int i = 0; i < 4; ++i) { const int idx = tid + 512 * i, row = idx >> 5, ch = idx & 31;
        s.v[i] = *(const GAS v4u*)(QKV + (rowbase + row) * 2048 + 1024 + h * 256 + 8 * ch); }
    if (tid < 64) { s.lf = LF[gbase + tid]; s.li = LI[gbase + tid]; }
}
template <bool PASSC>
__device__ __forceinline__ void stage_write(const Stage& s, LAS unsigned char* lds, int tid) {
#pragma unroll
    for (int i = 0; i < 2; ++i) { const int idx = tid + 512 * i, row = idx >> 4, ch = idx & 15;
        if (PASSC) *(LAS v4u*)(lds + L_Q + off_b(row, ch)) = s.q[i];
        *(LAS v4u*)(lds + L_K + off_b(row, ch)) = s.k[i]; }
#pragma unroll
    for (int i = 0; i < 4; ++i) { const int idx = tid + 512 * i, row = idx >> 5, ch = idx & 31;
        *(LAS v4u*)(lds + L_V + (ch >> 4) * 16384 + off_b(row, ch & 15)) = s.v[i]; }
}

template <bool PASSC>
__device__ __forceinline__ void unit(Frame& F, const int l, const int un) {
    LAS unsigned char* lds = F.lds; LAS float* sc = (LAS float*)(lds + L_SC);
    int tid0 = F.tid; asm volatile("" : "+v"(tid0)); const int w = F.wave;
    const int seg = un & (NSEG - 1), bh = un >> 2, b = bh >> 2, h = bh & 3;
    const bf16* QKV = (const bf16*)(F.ws + WS_QKV); bf16* MIX = (bf16*)(F.ws + WS_MIX);
    const float* LF = (const float*)(F.ws + WS_LF); const float* LI = (const float*)(F.ws + WS_LI);
    float* SEGC = (float*)(F.ws + WS_SEGC); float* SEGN = (float*)(F.ws + WS_SEGN); float* SEGS = (float*)(F.ws + WS_SEGS);
    const size_t row00 = (size_t)b * SEQ + (size_t)seg * CPS * CHUNK;
    const size_t g00 = (size_t)bh * SEQ + (size_t)seg * CPS * CHUNK;

    int tid = tid0, lane = tid0 & 63, fr = lane & 15, fq = lane >> 4;
    f32x4 C[8][2];
#pragma unroll
    for (int dt = 0; dt < 8; ++dt) { C[dt][0] = (f32x4){0.f, 0.f, 0.f, 0.f}; C[dt][1] = C[dt][0]; }
    float nreg = 0.f, m = PASSC ? 0.f : -1e30f, sum_bL = 0.f;
    if (PASSC) {
        for (int j = 0; j < seg; ++j) {
            const int uj = bh * NSEG + j; const float sb = SEGS[uj * 4 + 0], ml_ = SEGS[uj * 4 + 1];
            const float mn = fmaxf(m + sb, ml_), fa = __expf(m + sb - mn), fb = __expf(ml_ - mn);
            const float* cp = SEGC + (size_t)uj * 32768 + (size_t)(w * 16) * 256 + lane * 4;
#pragma unroll
            for (int dt = 0; dt < 8; ++dt)
#pragma unroll
                for (int vt = 0; vt < 2; ++vt) { const f32x4 cl = *(const GAS f32x4*)(cp + (dt * 2 + vt) * 256); C[dt][vt] = C[dt][vt] * fa + cl * fb; }
            if (tid < 128) nreg = nreg * fa + SEGN[uj * 128 + tid] * fb;
            m = mn;
        }
        if (tid < 128) sc[NV + tid] = nreg;
    }
    f32x4 gh[2];
    if (PASSC) { gh[0] = *(const GAS f32x4*)(F.head_norm + l * D + h * 256 + 32 * w + 4 * fq); gh[1] = *(const GAS f32x4*)(F.head_norm + l * D + h * 256 + 32 * w + 16 + 4 * fq); }

    Stage st;
    stage_load<PASSC>(st, QKV, LF, LI, row00, h, g00, tid);
    __syncthreads();
    stage_write<PASSC>(st, lds, tid);
    if (w == 0) m = chunk_scalars(sc, st.lf, st.li, m, lane, sum_bL);
    __syncthreads();

    const unsigned vimg = L_V + (w >> 2) * 16384, vc0 = 2 * (w & 3);
    for (int c = 0; c < CPS; ++c) {
        { int t_ = tid0; asm volatile("" : "+v"(t_)); tid = t_; lane = t_ & 63; fr = lane & 15; fq = lane >> 4; }
        const size_t rowb = row00 + (size_t)c * CHUNK;
        if (c + 1 < CPS) stage_load<PASSC>(st, QKV, LF, LI, rowb + CHUNK, h, g00 + (size_t)(c + 1) * CHUNK, tid);
        f32x4 Y[4][2]; v2u gate[4][2];
        if (PASSC) {
#pragma unroll
            for (int tt = 0; tt < 4; ++tt)
#pragma unroll
                for (int vt = 0; vt < 2; ++vt) gate[tt][vt] = *(const GAS v2u*)(MIX + (rowb + 16 * tt + fr) * 2048 + h * 256 + 32 * w + 16 * vt + 4 * fq);
            { const int ti = w >> 1, sh = w & 1, t = 16 * ti + fr; const float rt = sc[SR + t]; float rsum = 0.f;
#pragma unroll
              for (int s2 = 0; s2 < 2; ++s2) { const int si = 2 * sh + s2; f32x4 a = (f32x4){0.f, 0.f, 0.f, 0.f};
#pragma unroll
                  for (int ks = 0; ks < 4; ++ks) { const bf16x8 ka = *(const LAS bf16x8*)(lds + L_K + off_b(16 * si + fr, 4 * ks + fq));
                      const bf16x8 qb = *(const LAS bf16x8*)(lds + L_Q + off_b(t, 4 * ks + fq)); a = MFMA16(ka, qb, a); }
                  const f32x4 ps = *(const LAS f32x4*)(sc + SP + 16 * si + 4 * fq); f32x4 pv;
#pragma unroll
                  for (int e = 0; e < 4; ++e) { const int s = 16 * si + 4 * fq + e; pv[e] = (s <= t) ? a[e] * __expf(rt + ps[e]) : 0.f; }
                  rsum += (pv[0] + pv[1]) + (pv[2] + pv[3]);
                  v2u pk; pk.x = cvt_pk_bf16(pv[0], pv[1]); pk.y = cvt_pk_bf16(pv[2], pv[3]);
                  *(LAS v2u*)(lds + L_P + 128 * t + 16 * ((2 * si + (fq >> 1)) ^ ((t >> 1) & 7)) + 8 * (fq & 1)) = pk; }
              rsum += __shfl_xor(rsum, 16); rsum += __shfl_xor(rsum, 32);
              if (fq == 0) sc[RSP + sh * 64 + t] = rsum; }
            { const int t = tid >> 3, part = tid & 7; float a = 0.f;
#pragma unroll
              for (int hh = 0; hh < 2; ++hh) { const v4u qv = *(const LAS v4u*)(lds + L_Q + off_b(t, 2 * part + hh));
                  const f32x4 n0 = *(const LAS f32x4*)(sc + NV + 16 * part + 8 * hh), n1 = *(const LAS f32x4*)(sc + NV + 16 * part + 8 * hh + 4);
                  a += bf_lo(qv.x) * n0[0] + bf_hi(qv.x) * n0[1] + bf_lo(qv.y) * n0[2] + bf_hi(qv.y) * n0[3] + bf_lo(qv.z) * n1[0] + bf_hi(qv.z) * n1[1] + bf_lo(qv.w) * n1[2] + bf_hi(qv.w) * n1[3]; }
              a += __shfl_xor(a, 1); a += __shfl_xor(a, 2); a += __shfl_xor(a, 4);
              if (part == 0) sc[QN + t] = a; }
#pragma unroll
            for (int tt = 0; tt < 4; ++tt) { Y[tt][0] = (f32x4){0.f, 0.f, 0.f, 0.f}; Y[tt][1] = Y[tt][0]; }
#pragma unroll
            for (int ks = 0; ks < 4; ++ks) { const bf16x8 cf0 = pack8(C[2 * ks][0], C[2 * ks + 1][0]), cf1 = pack8(C[2 * ks][1], C[2 * ks + 1][1]);
#pragma unroll
                for (int tt = 0; tt < 4; ++tt) { const int t = 16 * tt + fr;
                    const v2u q0 = *(const LAS v2u*)(lds + L_Q + off_b(t, 4 * ks + (fq >> 1)) + 8 * (fq & 1)), q1 = *(const LAS v2u*)(lds + L_Q + off_b(t, 4 * ks + 2 + (fq >> 1)) + 8 * (fq & 1));
                    const bf16x8 qb = __builtin_bit_cast(bf16x8, (v4u){q0.x, q0.y, q1.x, q1.y});
                    Y[tt][0] = MFMA16(cf0, qb, Y[tt][0]); Y[tt][1] = MFMA16(cf1, qb, Y[tt][1]); } }
        }
        if (PASSC) __syncthreads();
        bf16x8 VT[2][2];
#pragma unroll
        for (int vt = 0; vt < 2; ++vt)
#pragma unroll
            for (int ks = 0; ks < 2; ++ks) VT[vt][ks] = cat8(tr_read(lds + vimg + tr_addr16(lane, vc0 + vt, ks, 0)), tr_read(lds + vimg + tr_addr16(lane, vc0 + vt, ks, 1)));
        if (PASSC) {
#pragma unroll
            for (int tt = 0; tt < 4; ++tt) { const int t = 16 * tt + fr; const float iw = sc[SIW + t];
                Y[tt][0] = Y[tt][0] * iw; Y[tt][1] = Y[tt][1] * iw;
#pragma unroll
                for (int ks = 0; ks < 2; ++ks) { const bf16x8 pb = *(const LAS bf16x8*)(lds + L_P + 128 * t + 16 * ((4 * ks + fq) ^ ((t >> 1) & 7)));
                    Y[tt][0] = MFMA16(VT[0][ks], pb, Y[tt][0]); Y[tt][1] = MFMA16(VT[1][ks], pb, Y[tt][1]); }
                const float den = sc[RSP + t] + sc[RSP + 64 + t] + iw * sc[QN + t];
                const float hs = 1.0f / fmaxf(fabsf(den), sc[SEI + t]);
                Y[tt][0] = Y[tt][0] * hs; Y[tt][1] = Y[tt][1] * hs;
                float ss = 0.f;
#pragma unroll
                for (int e = 0; e < 4; ++e) ss += Y[tt][0][e] * Y[tt][0][e] + Y[tt][1][e] * Y[tt][1][e];
                ss += __shfl_xor(ss, 16); ss += __shfl_xor(ss, 32);
                if (fq == 0) sc[HN + w * 64 + t] = ss; }
        }
        if (PASSC) {
            __syncthreads();
#pragma unroll
            for (int tt = 0; tt < 4; ++tt) { const int t = 16 * tt + fr; float tot = 0.f;
#pragma unroll
                for (int ww = 0; ww < 8; ++ww) tot += sc[HN + ww * 64 + t];
                const float rn = rsqrtf(tot * (1.0f / 256.0f) + EPS);
#pragma unroll
                for (int vt = 0; vt < 2; ++vt) { const v2u gt = gate[tt][vt]; const f32x4 y = Y[tt][vt] * rn * gh[vt];
                    v2u o; o.x = cvt_pk_bf16(y[0] * bf_lo(gt.x), y[1] * bf_hi(gt.x)); o.y = cvt_pk_bf16(y[2] * bf_lo(gt.y), y[3] * bf_hi(gt.y));
                    *(GAS v2u*)(MIX + (rowb + t) * 2048 + h * 256 + 32 * w + 16 * vt + 4 * fq) = o; } }
        }
        { const float decay = sc[MISC];
#pragma unroll
          for (int dt = 0; dt < 8; ++dt) { C[dt][0] = C[dt][0] * decay; C[dt][1] = C[dt][1] * decay; }
#pragma unroll
          for (int ks = 0; ks < 2; ++ks) {
              const f32x4 w0 = *(const LAS f32x4*)(sc + SW + 32 * ks + 8 * fq), w1 = *(const LAS f32x4*)(sc + SW + 32 * ks + 8 * fq + 4);
              const bf16x8 vw0 = scale8(VT[0][ks], w0, w1), vw1 = scale8(VT[1][ks], w0, w1);
#pragma unroll
              for (int dt = 0; dt < 8; ++dt) { const bf16x8 kt = cat8(tr_read(lds + L_K + tr_addr16(lane, dt, ks, 0)), tr_read(lds + L_K + tr_addr16(lane, dt, ks, 1)));
                  C[dt][0] = MFMA16(kt, vw0, C[dt][0]); C[dt][1] = MFMA16(kt, vw1, C[dt][1]); } }
          if (tid < 128) { float a = nreg * decay;
#pragma unroll 8
              for (int s = 0; s < 64; ++s) { const unsigned short kv = *(const LAS unsigned short*)(lds + L_K + off_b(s, tid >> 3) + 2 * (tid & 7)); a += sc[SW + s] * __builtin_bit_cast(float, (unsigned)kv << 16); }
              nreg = a; } }
        __syncthreads();
        if (PASSC && tid < 128) sc[NV + tid] = nreg;
        if (c + 1 < CPS) { stage_write<PASSC>(st, lds, tid); if (w == 0) m = chunk_scalars(sc, st.lf, st.li, m, lane, sum_bL); }
        __syncthreads();
    }
    if (!PASSC) {
        float* cp = SEGC + (size_t)un * 32768 + (size_t)(w * 16) * 256 + lane * 4;
#pragma unroll
        for (int dt = 0; dt < 8; ++dt)
#pragma unroll
            for (int vt = 0; vt < 2; ++vt) *(GAS f32x4*)(cp + (dt * 2 + vt) * 256) = C[dt][vt];
        if (tid < 128) SEGN[un * 128 + tid] = nreg;
        if (tid == 0) { SEGS[un * 4 + 0] = sum_bL; SEGS[un * 4 + 1] = m; }
    }
}
}

#ifdef DBG
constexpr int NLAYERS_RUN = 1;
#else
constexpr int NLAYERS_RUN = DEPTH;
#endif
struct Args { const float* in[10]; float* out; unsigned char* ws; };
#define REFRESH() do { int t_ = threadIdx.x; asm volatile("" : "+v"(t_)); F.tid = t_; F.lane = t_ & 63; } while (0)
__global__ void __launch_bounds__(NWAVES * 64, 2) hymba_fwd(Args args) {
    extern __shared__ __attribute__((aligned(16))) unsigned char lds_raw[];
    Frame F;
    F.lds = (LAS unsigned char*)lds_raw;
    F.tid = threadIdx.x; F.lane = F.tid & 63; F.wave = __builtin_amdgcn_readfirstlane(F.tid >> 6);
    F.G = gridDim.x; { const int bx = blockIdx.x; F.vcu = (F.G % 8 == 0) ? (bx % 8) * (F.G / 8) + bx / 8 : bx; }
    F.x = args.in[0]; F.norm_pre = args.in[1]; F.norm_post = args.in[2]; F.w_in = args.in[3]; F.b_i = args.in[4]; F.b_f = args.in[5];
    F.head_norm = args.in[6]; F.conv_w = args.in[7]; F.conv_norm = args.in[8]; F.w_out = args.in[9]; F.out = args.out; F.ws = args.ws;
    volatile LAS unsigned* MISC = (volatile LAS unsigned*)(F.lds + MISC_OFF);
    if (F.tid < 4) MISC[F.tid] = 0u;
    __syncthreads();
    XcdBarrier bar = xcd_barrier_post((unsigned*)(F.ws + WS_CTL) + CW_BAR, MISC);

#ifndef NO_PREP
    REFRESH(); prep_phase(F);
#endif
    xcd_barrier(bar);
#ifndef NO_THIN
    REFRESH(); thin_phase(F, 0, true);
#endif
    xcd_barrier(bar);
#pragma unroll 1
    for (int l = 0; l < NLAYERS_RUN; ++l) {
#ifndef NO_G1
        {
            pg8::Gemm g{(const pg8::bf16_t*)(F.ws + WS_XB), (const pg8::bf16_t*)(F.ws + WS_BT1) + (size_t)l * N1 * D, MTOK, N1, D};
            pg8::StaticOrder S; S.init(MTOK, N1, F.G, (int)blockIdx.x);
            Epi1 E{(bf16*)(F.ws + WS_QKV), (bf16*)(F.ws + WS_MIX), (const float*)(F.ws + WS_RSTD), F.conv_w + (size_t)l * 3 * DCONV, F.conv_norm + (size_t)l * DCONV,
                   (float*)(F.ws + WS_FIX), F.lds + EPI_OFF, (bf16*)(F.ws + WS_DBG)};
            pg8::gemm_phase<Epi1, pg8::StaticOrder, true, true>(F.lds, g, S, E);
        }
#endif
        xcd_barrier(bar);
#ifndef NO_MA
        REFRESH(); conv_fixup(F, l); REFRESH();
        for (int un = blockIdx.x; un < NUNIT; un += F.G) ml::unit<false>(F, l, un);
#endif
        xcd_barrier(bar);
#ifndef NO_MC
        REFRESH();
        for (int un = blockIdx.x; un < NUNIT; un += F.G) ml::unit<true>(F, l, un);
#endif
        xcd_barrier(bar);
#ifndef NO_G2
        {
            pg8::Gemm g{(const pg8::bf16_t*)(F.ws + WS_MIX), (const pg8::bf16_t*)(F.ws + WS_BT2) + (size_t)l * D * DMIX, MTOK, D, DMIX};
            pg8::StaticOrder S; S.init(MTOK, D, F.G, (int)blockIdx.x);
            Epi2 E{(bf16*)(F.ws + WS_OUT)};
            pg8::gemm_phase<Epi2, pg8::StaticOrder, true, true>(F.lds, g, S, E);
        }
#endif
        xcd_barrier(bar);
#ifndef NO_THIN
        REFRESH(); thin_phase(F, l + 1, l + 1 < NLAYERS_RUN);
#endif
        if (l + 1 < NLAYERS_RUN) xcd_barrier(bar);
    }
}

#ifdef DBG
constexpr size_t DBG_RES = 65536;
__device__ __forceinline__ float dbg_bf(bf16 v) { return __builtin_bit_cast(float, (unsigned)v << 16); }
__device__ float dbg_bsum(float v, float* sh) {
    __syncthreads(); sh[threadIdx.x] = v; __syncthreads();
    for (int o = 128; o > 0; o >>= 1) { if ((int)threadIdx.x < o) sh[threadIdx.x] += sh[threadIdx.x + o]; __syncthreads(); }
    const float r = sh[0]; __syncthreads(); return r;
}
__device__ float dbg_rstd(const float* xrow, float* sh) { float s = 0.f; for (int k = threadIdx.x; k < D; k += 256) s += xrow[k] * xrow[k]; return rsqrtf(dbg_bsum(s, sh) * (1.0f / D) + EPS); }
__device__ float dbg_dot(const float* xrow, const float* gp, const float* W, int col, float* sh) {
    float s = 0.f; for (int k = threadIdx.x; k < D; k += 256) s += xrow[k] * gp[k] * W[(size_t)k * INCOLS + col]; return dbg_bsum(s, sh);
}
__device__ void dbg_acc(float* res, int bit, float e2, float r2) { if (threadIdx.x == 0) { atomicAdd(res + bit, e2); atomicAdd(res + 16 + bit, r2); } }
constexpr int DBG_N1 = 48, DBG_N2 = 24, DBG_NG = 16, DBG_N3 = 12, DBG_N4 = 8, DBG_N5 = 32;
__global__ void __launch_bounds__(256) dbg_check(Args a) {
    __shared__ float sh[256]; __shared__ float vals[3][4][64]; __shared__ float Fc[4096]; __shared__ float scs[4096]; __shared__ float tot[256];
    const float* x = a.in[0]; const float* gp = a.in[1]; const float* W = a.in[3]; const float* cw = a.in[7]; const float* cg = a.in[8];
    float* res = (float*)(a.ws + WS_CTL + DBG_RES);
    const bf16* QKV = (const bf16*)(a.ws + WS_QKV); const bf16* MIX = (const bf16*)(a.ws + WS_MIX); const bf16* DBGG = (const bf16*)(a.ws + WS_DBG);
    const float* LI = (const float*)(a.ws + WS_LI); const float* LF = (const float*)(a.ws + WS_LF);
    int id = blockIdx.x; const int tid = threadIdx.x;
    if (id < DBG_N1) {
        const int i = id, r = (int)(((unsigned)i * 7919u + 13u) & 65535u), pn = i & 7, ci = (i * 37 + 5) & 255, cc = 256 * pn + ci;
        const float rs = dbg_rstd(x + (size_t)r * D, sh);
        const float ref = dbg_dot(x + (size_t)r * D, gp, W, cc, sh) * rs * (cc < 512 ? 0.08838834764831845f : 1.0f);
        const float val = dbg_bf(QKV[(size_t)r * 2048 + cc]);
        dbg_acc(res, 0, (val - ref) * (val - ref), ref * ref); return;
    }
    id -= DBG_N1;
    if (id < DBG_N2) {
        const int i = id, r = (int)(((unsigned)i * 104729u + 77u) & 65535u), ch = (i * 131 + 9) & 1023;
        const float rs = dbg_rstd(x + (size_t)r * D, sh);
        const float o = dbg_dot(x + (size_t)r * D, gp, W, 2048 + ch, sh) * rs, z = dbg_dot(x + (size_t)r * D, gp, W, 3072 + ch, sh) * rs;
        const float ref = z / (1.f + expf(-z)) / (1.f + expf(-o));
        const float val = dbg_bf(DBGG[(size_t)r * 1024 + ch]);
        dbg_acc(res, 0, (val - ref) * (val - ref), ref * ref); return;
    }
    id -= DBG_N2;
    if (id < DBG_NG) {
        const int i = id, r = (int)(((unsigned)i * 31337u + 5u) & 65535u), h = i & 3, b = r >> 12, t = r & 4095;
        const float rs = dbg_rstd(x + (size_t)r * D, sh);
        const float ip = dbg_dot(x + (size_t)r * D, gp, W, 4096 + h, sh) * rs + a.in[4][h], fp = dbg_dot(x + (size_t)r * D, gp, W, 4100 + h, sh) * rs + a.in[5][h];
        const float lfr = fminf(fp, 0.f) - log1pf(expf(-fabsf(fp)));
        const float v1 = LI[(size_t)(b * 4 + h) * SEQ + t], v2 = LF[(size_t)(b * 4 + h) * SEQ + t];
        dbg_acc(res, 0, (v1 - ip) * (v1 - ip) + (v2 - lfr) * (v2 - lfr), ip * ip + lfr * lfr); return;
    }
    id -= DBG_NG;
    if (id < 5 * DBG_N3) {
        const int cat = id / DBG_N3, i = id % DBG_N3, g = (i * 5 + cat) & 15;
        int rb = (int)(((unsigned)(i + 1) * 2654435761u >> 8) & 65535u) & ~255, off;
        if (cat == 0) off = 5 + (i % 10);
        else if (cat == 1) off = 16 * (1 + i % 3) + (i & 1);
        else if (cat == 2) off = 64 * (1 + i % 3) + (i & 1);
        else if (cat == 3) { off = (i & 1); if (((rb >> 8) & 15) == 0) rb += 256; }
        else { rb &= ~4095; off = (i & 1); }
        const int r = rb + off, t = r & (SEQ - 1), qn = tid >> 6, c = tid & 63, col = 4104 + 1024 * qn + 64 * g + c;
        for (int j = 0; j < 3; ++j) {
            const int tj = t - 2 + j; float v = 0.f;
            if (tj >= 0) { const float* xr = x + (size_t)(r - 2 + j) * D; const float rs = dbg_rstd(xr, sh);
                float s = 0.f; for (int k = 0; k < D; ++k) s += xr[k] * gp[k] * W[(size_t)k * INCOLS + col]; v = s * rs; }
            vals[j][qn][c] = v;
        }
        __syncthreads();
        float y = 0.f, bc = 0.f;
        if (qn == 0) { const int ch = 64 * g + c;
            const float cu0 = vals[0][0][c] * vals[0][2][c], cu1 = vals[1][0][c] * vals[1][2][c], cu2 = vals[2][0][c] * vals[2][2][c];
            bc = vals[2][1][c] * (cw[ch] * cu0 + cw[1024 + ch] * cu1 + cw[2048 + ch] * cu2); }
        const float ss = dbg_bsum(qn == 0 ? bc * bc : 0.f, sh);
        float e2 = 0.f, r2 = 0.f;
        if (qn == 0) { const int ch = 64 * g + c; const float z = vals[2][3][c]; y = z / (1.f + expf(-z)) * bc * rsqrtf(ss * (1.0f / 64.0f) + EPS) * cg[ch];
            const float val = dbg_bf(MIX[(size_t)r * 2048 + 1024 + ch]); e2 = (val - y) * (val - y); r2 = y * y; }
        e2 = dbg_bsum(e2, sh); r2 = dbg_bsum(r2, sh);
        dbg_acc(res, cat < 3 ? 1 : 2, e2, r2); return;
    }
    id -= 5 * DBG_N3;
    if (id < 3 * DBG_N4) {
        const int cat = id / DBG_N4, i = id % DBG_N4, bh = (i * 13 + cat * 7) & 63, b = bh >> 2, h = bh & 3;
        int t;
        if (cat == 0) { const int tt[8] = {0, 1, 5, 17, 31, 37, 62, 63}; t = tt[i]; }
        else if (cat == 1) { const int tt[8] = {64, 65, 100, 127, 128, 500, 1000, 1023}; t = tt[i]; }
        else { const int tt[8] = {1024, 1025, 1500, 2047, 2048, 3000, 3071, 4095}; t = tt[i]; }
        const size_t rbase = (size_t)b * SEQ, r = rbase + t;
        { float run = 0.f; for (int j = 0; j < 16; ++j) { run += LF[(size_t)bh * SEQ + tid * 16 + j]; Fc[tid * 16 + j] = run; } tot[tid] = run; }
        __syncthreads();
        if (tid == 0) { float run = 0.f; for (int j = 0; j < 256; ++j) { const float v = tot[j]; tot[j] = run; run += v; } }
        __syncthreads();
        for (int j = 0; j < 16; ++j) Fc[tid * 16 + j] += tot[tid];
        __syncthreads();
        const float Ft = Fc[t];
        float dsum = 0.f;
        for (int s = tid; s <= t; s += 256) { float d = 0.f;
            for (int k = 0; k < 128; ++k) d += dbg_bf(QKV[r * 2048 + h * 128 + k]) * dbg_bf(QKV[(rbase + s) * 2048 + 512 + h * 128 + k]);
            const float w = expf(Ft - Fc[s] + LI[(size_t)bh * SEQ + s]) * d; scs[s] = w; dsum += w; }
        const float den = dbg_bsum(dsum, sh);
        float num = 0.f;
        for (int s = 0; s <= t; ++s) num += scs[s] * dbg_bf(QKV[(rbase + s) * 2048 + 1024 + h * 256 + tid]);
        const float hv = num / fmaxf(fabsf(den), 1.0f);
        const float ssq = dbg_bsum(hv * hv, sh);
        const float ref = dbg_bf(DBGG[r * 1024 + h * 256 + tid]) * hv * rsqrtf(ssq * (1.0f / 256.0f) + EPS) * a.in[6][h * 256 + tid];
        const float val = dbg_bf(MIX[r * 2048 + h * 256 + tid]);
        const float e2 = dbg_bsum((val - ref) * (val - ref), sh), r2 = dbg_bsum(ref * ref, sh);
        dbg_acc(res, 3 + cat, e2, r2); return;
    }
    id -= 3 * DBG_N4;
    if (id < DBG_N5) {
        const int i = id, r = (int)(((unsigned)i * 48271u + 11u) & 65535u), c = (i * 173 + 3) & 1023;
        const bf16* OUTB = (const bf16*)(a.ws + WS_OUT);
        float s = 0.f; for (int k = tid; k < DMIX; k += 256) s += dbg_bf(MIX[(size_t)r * 2048 + k]) * a.in[9][(size_t)k * D + c];
        const float ref = dbg_bsum(s, sh), val = dbg_bf(OUTB[(size_t)r * D + c]);
        float q = 0.f; for (int k = tid; k < D; k += 256) { const float o = dbg_bf(OUTB[(size_t)r * D + k]); q += o * o; }
        const float rs = rsqrtf(dbg_bsum(q, sh) * (1.0f / D) + EPS);
        const float ref2 = x[(size_t)r * D + c] + val * rs * a.in[2][c], val2 = a.out[(size_t)r * D + c];
        dbg_acc(res, 6, (val - ref) * (val - ref) + (val2 - ref2) * (val2 - ref2), ref * ref + ref2 * ref2); return;
    }
}
__global__ void __launch_bounds__(256) dbg_report(Args a) {
    const float* res = (const float*)(a.ws + WS_CTL + DBG_RES);
    int mask = 0;
    for (int i = 0; i < 7; ++i) { const float e = res[i], r = res[16 + i]; if (!(e <= 0.0025f * r) || !(r > 0.f)) mask |= 1 << i; }
    const size_t n = (size_t)MTOK * D;
    for (size_t i = (size_t)blockIdx.x * 256 + threadIdx.x; i < n; i += (size_t)gridDim.x * 256) a.out[i] = 0.f;
    if (blockIdx.x == 0 && threadIdx.x == 0) a.out[0] = ldexpf(1.0f, (mask < 120 ? mask : 120) + 4);
}
#endif
extern "C" void kernel_launch(void* const* d_in, const int* in_sizes, int n_in, void* d_out, int out_size, void* d_ws, size_t ws_size, hipStream_t stream) {
    static int grid = 0;
    if (grid == 0) {
        if (n_in != 10 || out_size != MTOK * D || ws_size < WS_END) { fprintf(stderr, "kernel_launch: unexpected shapes (n_in %d, out %d, ws %zu)\n", n_in, out_size, ws_size); grid = -1; return; }
        int dev = 0, cus = 0, per_cu = 0;
        if (hipGetDevice(&dev) != hipSuccess || hipDeviceGetAttribute(&cus, hipDeviceAttributeMultiprocessorCount, dev) != hipSuccess) { grid = -1; return; }
        if (hipFuncSetAttribute((const void*)hymba_fwd, hipFuncAttributeMaxDynamicSharedMemorySize, LDS_BYTES) != hipSuccess) { fprintf(stderr, "kernel_launch: hipFuncSetAttribute failed\n"); grid = -1; return; }
        if (hipOccupancyMaxActiveBlocksPerMultiprocessor(&per_cu, (const void*)hymba_fwd, NWAVES * 64, LDS_BYTES) != hipSuccess || per_cu < 1) { fprintf(stderr, "kernel_launch: occupancy query says %d\n", per_cu); grid = -1; return; }
        grid = cus;
    }
    if (grid <= 0) return;
    if (hipMemsetAsync((char*)d_ws + WS_CTL, 0, CTL_ZERO_BYTES, stream) != hipSuccess) return;
    Args a{};
    for (int i = 0; i < 10; ++i) a.in[i] = (const float*)d_in[i];
    a.out = (float*)d_out; a.ws = (unsigned char*)d_ws;
    hipLaunchKernelGGL(hymba_fwd, dim3(grid), dim3(NWAVES * 64), LDS_BYTES, stream, a);
#ifdef DBG
    hipLaunchKernelGGL(dbg_check, dim3(DBG_N1 + DBG_N2 + DBG_NG + 5 * DBG_N3 + 3 * DBG_N4 + DBG_N5), dim3(256), 0, stream, a);
    hipLaunchKernelGGL(dbg_report, dim3(1024), dim3(256), 0, stream, a);
#endif
}
```

```cpp
#include <hip/hip_runtime.h>
#include <cstdio>
#include <cstdint>
namespace pg8 {
#define PG8_LAS __attribute__((address_space(3)))
typedef unsigned short bf16_t;
typedef short bf16x8 __attribute__((ext_vector_type(8)));
typedef float f32x4 __attribute__((ext_vector_type(4)));
typedef unsigned u32x4 __attribute__((ext_vector_type(4)));
constexpr int BM = 256, BK = 64, HALF = 128, HTB = HALF * BK * 2  , STAGE_BYTES = 8 * HTB, NXCD = 8, WGM = 8;

__host__ __device__ __forceinline__ int lds_byte(int r, int c) { const int st = (r >> 4) * 2 + (c >> 5), rr = r & 15, cc = c & 31, ob = rr * 64 + cc * 2; return st * 1024 + (ob ^ (((ob >> 9) & 1) << 5)); }
__host__ __device__ __forceinline__ void stage_rc(int b, int& R, int& C) { const int st = b / 1024, sb = b % 1024, swz = sb ^ (((sb >> 9) & 1) << 5); R = (st >> 1) * 16 + swz / 64; C = (st & 1) * 32 + (swz % 64) / 2; }
__host__ __device__ __forceinline__ int perm32(int rho) { const int n = rho >> 4, i = rho & 15; return 8 * (i >> 2) + 4 * n + (i & 3); }

struct Unit { int pm, pn; };
struct Gemm { const bf16_t* A; const bf16_t* Bt; int M, N, K; };

struct StaticOrder {
    int nM, nN, nwg, G, c;
    __host__ __device__ void init(int M, int N, int G_, int c_) { nM = M / BM; nN = N / BM; nwg = nM * nN; G = G_; c = c_; }
    __host__ __device__ bool next(int i, Unit& u) const {
        const long L = (long)i * G + c; if (L >= nwg) return false;
        int wgid = (int)L; { const int q = nwg / NXCD, r = nwg % NXCD, xcd = wgid % NXCD, off = wgid / NXCD; wgid = (xcd < r ? xcd * (q + 1) : r * (q + 1) + (xcd - r) * q) + off; }
        const int nig = WGM * nN, gid = wgid / nig, fm = gid * WGM, gsz = (nM - fm) < WGM ? (nM - fm) : WGM;
        u.pm = fm + ((wgid % nig) % gsz); u.pn = (wgid % nig) / gsz; return true;
    }
    __device__ __forceinline__ void a_ready(const Unit&) const {}
    __device__ __forceinline__ void done(const Unit&) const {}
};

__device__ __forceinline__ unsigned cvt_pk_bf16(float lo, float hi) { unsigned r; asm volatile("v_cvt_pk_bf16_f32 %0, %1, %2" : "=v"(r) : "v"(lo), "v"(hi)); return r; }
typedef float f32x2 __attribute__((ext_vector_type(2)));
template <class Epi, class Sched, bool ALIGN_EPI = false, bool SP2 = false>
__device__ __forceinline__ void gemm_phase(PG8_LAS unsigned char* lds, const Gemm g, const Sched& S, const Epi& E) {
    int tid_ = threadIdx.x; asm volatile("" : "+v"(tid_));
    const int tid = tid_, wid = __builtin_amdgcn_readfirstlane(tid >> 6), lane = tid & 63, wr = wid >> 2, wc = wid & 3, fr = lane & 15, fq = lane >> 4;
    const int K = g.K, nt = K / BK;
    unsigned voffA[2], voffB[2];
#pragma unroll
    for (int i = 0; i < 2; ++i) { int R, C; stage_rc(tid * 16 + i * 8192, R, C); const int Rb = Epi::PERM ? ((R & ~31) + perm32(R & 31)) : R;
        voffA[i] = (unsigned)(R * K + C) * 2u; voffB[i] = (unsigned)(Rb * K + C) * 2u; }
    const size_t kstep = (size_t)(BK * 2);
    const size_t hstep = (size_t)HALF * K * 2;
    const size_t tstep = 2 * hstep;
    const unsigned ldsw = (unsigned)wid * 1024u;
    const int aoff = lds_byte(wr * 64 + fr, fq * 8), boff = lds_byte(wc * 32 + fr, fq * 8);
#define PG8_SA(b, h) (((b) * 2 + (h)) * HTB)
#define PG8_SB(b, h) ((4 + (b) * 2 + (h)) * HTB)
#define PG8_STAGE(bufoff, gbase, voff) do { _Pragma("unroll") for (int _i = 0; _i < 2; ++_i) \
        __builtin_amdgcn_global_load_lds((const unsigned*)((const char*)(gbase) + (voff)[_i]), (PG8_LAS unsigned*)(lds + (bufoff) + ldsw + _i * 8192), 16, 0, 0); } while (0)
#define PG8_LDA(dst, b, h) do { _Pragma("unroll") for (int m = 0; m < 4; ++m) _Pragma("unroll") for (int k = 0; k < 2; ++k) dst[m][k] = *(const PG8_LAS bf16x8*)(lds + PG8_SA(b, h) + aoff + m * 2048 + k * 1024); } while (0)
#define PG8_LDB(dst, b, h) do { _Pragma("unroll") for (int n = 0; n < 2; ++n) _Pragma("unroll") for (int k = 0; k < 2; ++k) dst[n][k] = *(const PG8_LAS bf16x8*)(lds + PG8_SB(b, h) + boff + n * 2048 + k * 1024); } while (0)
#define PG8_MMA(ai, bj, At, Bt) do { __builtin_amdgcn_s_setprio(1); _Pragma("unroll") for (int m = 0; m < 4; ++m) _Pragma("unroll") for (int n = 0; n < 2; ++n) _Pragma("unroll") for (int k = 0; k < 2; ++k) \
        acc[ai][bj][m][n] = __builtin_amdgcn_mfma_f32_16x16x32_bf16(Bt[n][k], At[m][k], acc[ai][bj][m][n], 0, 0, 0); __builtin_amdgcn_s_setprio(0); } while (0)
#define PG8_WAIT_V(n) asm volatile("s_waitcnt vmcnt(" #n ")" ::: "memory")
#define PG8_WAIT_L(n) asm volatile("s_waitcnt lgkmcnt(" #n ")" ::: "memory")
#define PG8_BAR __builtin_amdgcn_s_barrier()
#define PG8_SCHED __builtin_amdgcn_sched_barrier(0)
    Unit cur, nxt; int ui = 0;
    if (!S.next(0, cur)) return;
    f32x4 acc[2][2][4][2];
#pragma unroll
    for (int a = 0; a < 2; ++a)
#pragma unroll
        for (int b = 0; b < 2; ++b)
#pragma unroll
            for (int m = 0; m < 4; ++m)
#pragma unroll
                for (int n = 0; n < 2; ++n) acc[a][b][m][n] = (f32x4){0.f, 0.f, 0.f, 0.f};
    bf16x8 At[4][2], B0[2][2], B1[2][2];
    const char* cA = (const char*)g.A + (size_t)cur.pm * tstep; const char* cB = (const char*)g.Bt + (size_t)cur.pn * tstep;
    S.a_ready(cur);
    if constexpr (SP2) {
        PG8_STAGE(PG8_SB(0, 0), cB, voffB); PG8_STAGE(PG8_SB(0, 1), cB + hstep, voffB); PG8_STAGE(PG8_SA(0, 0), cA, voffA); PG8_STAGE(PG8_SA(0, 1), cA + hstep, voffA);
        if (wr == 1) PG8_BAR;
        PG8_WAIT_V(2); PG8_BAR;
        PG8_STAGE(PG8_SB(1, 0), cB + kstep, voffB); PG8_STAGE(PG8_SA(1, 0), cA + kstep, voffA); PG8_STAGE(PG8_SB(1, 1), cB + hstep + kstep, voffB);
        PG8_WAIT_V(6); PG8_BAR;
    } else {
        PG8_STAGE(PG8_SB(0, 0), cB, voffB); PG8_STAGE(PG8_SA(0, 0), cA, voffA); PG8_STAGE(PG8_SB(0, 1), cB + hstep, voffB); PG8_STAGE(PG8_SA(0, 1), cA + hstep, voffA);
        if (wr == 1) PG8_BAR;
        PG8_WAIT_V(4); PG8_BAR;
        PG8_STAGE(PG8_SB(1, 0), cB + kstep, voffB); PG8_STAGE(PG8_SA(1, 0), cA + kstep, voffA); PG8_STAGE(PG8_SB(1, 1), cB + hstep + kstep, voffB);
        PG8_WAIT_V(6); PG8_BAR;
    }
    for (;;) {
        const bool has_next = S.next(ui + 1, nxt);
        const char* nA = has_next ? (const char*)g.A + (size_t)nxt.pm * tstep : cA; const char* nB = has_next ? (const char*)g.Bt + (size_t)nxt.pn * tstep : cB;
        for (int t = 0; t < nt; t += 2) {
            const bool last = (t == nt - 2);
            const char* a1 = cA + (size_t)(t + 1) * kstep;
            const char* a2 = last ? nA : cA + (size_t)(t + 2) * kstep; const char* b2 = last ? nB : cB + (size_t)(t + 2) * kstep;
            const char* a3 = a2 + kstep; const char* b3 = b2 + kstep;
            if (last && has_next) S.a_ready(nxt);
            if constexpr (SP2) {
            PG8_LDB(B0, 0, 0); PG8_LDB(B1, 0, 1); PG8_SCHED; PG8_LDA(At, 0, 0); PG8_STAGE(PG8_SA(1, 1), a1 + hstep, voffA);
            PG8_WAIT_V(8); PG8_WAIT_L(0); PG8_BAR; PG8_MMA(0, 0, At, B0); PG8_MMA(0, 1, At, B1); PG8_BAR; PG8_SCHED;
            PG8_LDA(At, 0, 1); PG8_STAGE(PG8_SB(0, 0), b2, voffB); PG8_STAGE(PG8_SB(0, 1), b2 + hstep, voffB); PG8_STAGE(PG8_SA(0, 0), a2, voffA);
            PG8_WAIT_V(8); PG8_WAIT_L(0); PG8_BAR; PG8_MMA(1, 0, At, B0); PG8_MMA(1, 1, At, B1); PG8_BAR; PG8_SCHED;
            PG8_LDB(B0, 1, 0); PG8_LDB(B1, 1, 1); PG8_SCHED; PG8_LDA(At, 1, 0); PG8_STAGE(PG8_SA(0, 1), a2 + hstep, voffA);
            PG8_WAIT_V(8); PG8_WAIT_L(0); PG8_BAR; PG8_MMA(0, 0, At, B0); PG8_MMA(0, 1, At, B1); PG8_BAR; PG8_SCHED;
            PG8_LDA(At, 1, 1); PG8_STAGE(PG8_SB(1, 0), b3, voffB); PG8_STAGE(PG8_SB(1, 1), b3 + hstep, voffB); PG8_STAGE(PG8_SA(1, 0), a3, voffA);
            PG8_WAIT_V(8); PG8_WAIT_L(0); PG8_BAR; PG8_MMA(1, 0, At, B0); PG8_MMA(1, 1, At, B1); PG8_BAR; PG8_SCHED;
            } else {
            PG8_LDB(B0, 0, 0); PG8_SCHED; PG8_LDA(At, 0, 0); PG8_STAGE(PG8_SA(1, 1), a1 + hstep, voffA);
            PG8_WAIT_L(8); PG8_BAR; PG8_WAIT_L(0); PG8_MMA(0, 0, At, B0); PG8_BAR; PG8_SCHED;
            PG8_LDB(B1, 0, 1); PG8_STAGE(PG8_SB(0, 0), b2, voffB);
            PG8_BAR; PG8_WAIT_L(0); PG8_MMA(0, 1, At, B1); PG8_BAR;
            PG8_LDA(At, 0, 1); PG8_STAGE(PG8_SA(0, 0), a2, voffA);
            PG8_BAR; PG8_WAIT_L(0); PG8_MMA(1, 0, At, B0); PG8_BAR; PG8_SCHED;
            PG8_STAGE(PG8_SB(0, 1), b2 + hstep, voffB);
            PG8_WAIT_V(6); PG8_BAR; PG8_MMA(1, 1, At, B1); PG8_BAR;
            PG8_LDB(B0, 1, 0); PG8_SCHED; PG8_LDA(At, 1, 0); PG8_STAGE(PG8_SA(0, 1), a2 + hstep, voffA);
            PG8_WAIT_L(8); PG8_BAR; PG8_WAIT_L(0); PG8_MMA(0, 0, At, B0); PG8_BAR; PG8_SCHED;
            PG8_LDB(B1, 1, 1); PG8_STAGE(PG8_SB(1, 0), b3, voffB);
            PG8_BAR; PG8_WAIT_L(0); PG8_MMA(0, 1, At, B1); PG8_BAR;
            PG8_LDA(At, 1, 1); PG8_STAGE(PG8_SA(1, 0), a3, voffA);
            PG8_BAR; PG8_WAIT_L(0); PG8_MMA(1, 0, At, B0); PG8_BAR; PG8_SCHED;
            PG8_STAGE(PG8_SB(1, 1), b3 + hstep, voffB);
            PG8_WAIT_V(6); PG8_BAR; PG8_MMA(1, 1, At, B1); PG8_BAR;
            }
        }
        if constexpr (ALIGN_EPI) { if (wr == 0) PG8_BAR; }
        if constexpr (!Epi::AFTER_DRAIN) { E(acc, cur, wr, wc, fr, fq); S.done(cur); }
        if (!has_next) break;
#pragma unroll
        for (int a = 0; a < 2; ++a)
#pragma unroll
            for (int b = 0; b < 2; ++b)
#pragma unroll
                for (int m = 0; m < 4; ++m)
#pragma unroll
                    for (int n = 0; n < 2; ++n) acc[a][b][m][n] = (f32x4){0.f, 0.f, 0.f, 0.f};
        cur = nxt; cA = nA; cB = nB; ++ui;
        if constexpr (ALIGN_EPI) { if (wr == 1) PG8_BAR; }
    }
    PG8_WAIT_V(0);
    if constexpr (!ALIGN_EPI) { if (wr == 0) PG8_BAR; }
    PG8_BAR;
    if constexpr (Epi::AFTER_DRAIN) { E.fused(acc, cur, wr, wc, fr, fq, lds, wid, lane); S.done(cur); }
#undef PG8_SA
#undef PG8_SB
#undef PG8_STAGE
#undef PG8_LDA
#undef PG8_LDB
#undef PG8_MMA
#undef PG8_WAIT_V
#undef PG8_WAIT_L
#undef PG8_BAR
#undef PG8_SCHED
}
}

constexpr int D = 1024, BATCH = 16, SEQ = 4096, DEPTH = 4, MTOK = BATCH * SEQ;
constexpr int NH = 4, DV = 256, DQK = 128, INCOLS = 8200, N1 = 8192, DMIX = 2048, DCONV = 1024;
constexpr int CHUNK = 64, NCH = SEQ / CHUNK, NSEG = 4, CPS = NCH / NSEG;
constexpr int NUNIT = BATCH * NH * NSEG;
constexpr float EPS = 1e-6f;
constexpr int NWAVES = 8;

constexpr size_t MiB = 1u << 20;
constexpr size_t WS_CTL = 0, CTL_ZERO_BYTES = 65536;
constexpr size_t WS_BT1 = 2 * MiB;
constexpr size_t WS_BT2 = 66 * MiB;
constexpr size_t WS_WG = 82 * MiB;
constexpr size_t WS_RSTD = 83 * MiB;
constexpr size_t WS_LI = 84 * MiB;
constexpr size_t WS_LF = 85 * MiB;
constexpr size_t WS_FIX = 86 * MiB;
constexpr size_t FIX_ARR = 256 * 2 * 1024;
constexpr size_t WS_SEGC = 94 * MiB;
constexpr size_t WS_SEGN = 126 * MiB;
constexpr size_t WS_SEGS = 127 * MiB;
constexpr size_t WS_XB = 128 * MiB;
constexpr size_t WS_QKV = 256 * MiB;
constexpr size_t WS_MIX = 512 * MiB;
constexpr size_t WS_OUT = 768 * MiB;
constexpr size_t WS_END = 896 * MiB;
constexpr size_t WS_DBG = 896 * MiB;
constexpr int CW_BAR = 4096;

constexpr int RING_BYTES = 131072;
constexpr int EPI_OFF = RING_BYTES;
constexpr int CONVW_OFF = EPI_OFF + 8192;
constexpr int LDS_BYTES = 163840;
constexpr int MISC_OFF = LDS_BYTES - 512;

#define GAS __attribute__((address_space(1)))
#define LAS __attribute__((address_space(3)))
typedef unsigned short bf16;
typedef unsigned v4u __attribute__((ext_vector_type(4)));
typedef unsigned v2u __attribute__((ext_vector_type(2)));
typedef float f32x4 __attribute__((ext_vector_type(4)));
typedef short bf16x8 __attribute__((ext_vector_type(8)));
typedef short s16x4 __attribute__((ext_vector_type(4)));
#define LDS_WAIT() asm volatile("s_waitcnt lgkmcnt(0)" ::: "memory")
#define VM_WAIT() asm volatile("s_waitcnt vmcnt(0)" ::: "memory")
using pg8::cvt_pk_bf16;
__device__ __forceinline__ float bf_lo(unsigned u) { return __builtin_bit_cast(float, u << 16); }
__device__ __forceinline__ float bf_hi(unsigned u) { return __builtin_bit_cast(float, u & 0xffff0000u); }
__device__ __forceinline__ float dpp_ror1(float v) { return __int_as_float(__builtin_amdgcn_mov_dpp(__float_as_int(v), 0x121, 0xf, 0xf, true)); }
__device__ __forceinline__ float dpp_ror2(float v) { return __int_as_float(__builtin_amdgcn_mov_dpp(__float_as_int(v), 0x122, 0xf, 0xf, true)); }
__device__ __forceinline__ float dpp_shr1(float old, float v) { return __int_as_float(__builtin_amdgcn_update_dpp(__float_as_int(old), __float_as_int(v), 0x111, 0xf, 0xf, false)); }
__device__ __forceinline__ float dpp_shr2(float old, float v) { return __int_as_float(__builtin_amdgcn_update_dpp(__float_as_int(old), __float_as_int(v), 0x112, 0xf, 0xf, false)); }
__device__ __forceinline__ float sigmoidf_(float x) { return 1.0f / (1.0f + __expf(-x)); }
__device__ __forceinline__ float xadd16(float v) { const auto r = __builtin_amdgcn_permlane16_swap(__float_as_uint(v), __float_as_uint(v), false, false); return __uint_as_float(r[0]) + __uint_as_float(r[1]); }
__device__ __forceinline__ float xadd32(float v) { const auto r = __builtin_amdgcn_permlane32_swap(__float_as_uint(v), __float_as_uint(v), false, false); return __uint_as_float(r[0]) + __uint_as_float(r[1]); }
#define DPP_ADD0(v, ctrl) ((v) + __int_as_float(__builtin_amdgcn_update_dpp(0, __float_as_int(v), (ctrl), 0xf, 0xf, false)))
__device__ __forceinline__ float wave_sum(float v) {
    v = DPP_ADD0(v, 0xB1); v = DPP_ADD0(v, 0x4E); v = DPP_ADD0(v, 0x124); v = DPP_ADD0(v, 0x128);
    return xadd32(xadd16(v));
}

#define XB_TMO      128
#define XB_XCNT(j)  (256  + 64 * (j))
#define XB_XSUB(j)  (1280 + 64 * (j))
#define XB_XGEN(j)  (2304 + 64 * (j))
#define XB_TOP      3328
#define XB_TOPGEN   3392
#define XCD_BAR_WORDS 3456
#define XB_SPIN_CAP (1u << 18)
__device__ __forceinline__ unsigned xb_ld(unsigned* p)              { return __hip_atomic_load(p, __ATOMIC_RELAXED, __HIP_MEMORY_SCOPE_AGENT); }
__device__ __forceinline__ unsigned xb_add(unsigned* p, unsigned v) { return __hip_atomic_fetch_add(p, v, __ATOMIC_RELAXED, __HIP_MEMORY_SCOPE_AGENT); }
__device__ __forceinline__ unsigned xb_xcc_id() { return (unsigned)__builtin_amdgcn_s_getreg((3 << 11) | 20) & 0xFu; }
#define XB_SPIN(cond, bar) do { unsigned _sp = 0; while (cond) { __builtin_amdgcn_s_sleep(1); \
    if ((++_sp & 255u) == 0u) { if (xb_ld(&(bar)[XB_TMO])) break; if (_sp > XB_SPIN_CAP) { atomicAdd(&(bar)[XB_TMO], 1u); break; } } } } while (0)
struct XcdBarrier { unsigned* bar; unsigned x; volatile LAS unsigned* st; };
__device__ __forceinline__ XcdBarrier xcd_barrier_post(unsigned* bar, volatile LAS unsigned* st) {
    XcdBarrier b; b.bar = bar; b.x = xb_xcc_id(); b.st = st;
    if (threadIdx.x == 0) (void)xb_add(&bar[XB_XCNT(b.x)], 1u);
    return b;
}
__device__ __forceinline__ void xcd_barrier_complete(unsigned* bar, unsigned x, unsigned& nloc, unsigned& nx) {
    const unsigned G = gridDim.x * gridDim.y * gridDim.z;
    unsigned sum, cnt, mine, sp = 0u;
    for (;;) {
        sum = 0u; cnt = 0u; mine = 0u;
#pragma unroll
        for (unsigned j = 0; j < 16; ++j) { const unsigned c = xb_ld(&bar[XB_XCNT(j)]); sum += c; cnt += (c > 0u) ? 1u : 0u; mine = (j == x) ? c : mine; }
        if (sum == G) break;
        __builtin_amdgcn_s_sleep(1);
        if ((++sp & 255u) == 0u) { if (xb_ld(&bar[XB_TMO])) break; if (sp > XB_SPIN_CAP) { atomicAdd(&bar[XB_TMO], 1u); break; } }
    }
    nloc = mine > 0u ? mine : 1u; nx = cnt > 0u ? cnt : 1u;
}
__device__ __forceinline__ void xcd_barrier(const XcdBarrier& b) {
    asm volatile("s_waitcnt vmcnt(0)" ::: "memory");
    __syncthreads();
    if (threadIdx.x == 0) {
        unsigned* bar = b.bar; const unsigned bx = xb_xcc_id();
        __builtin_amdgcn_s_waitcnt(0);
        unsigned nloc = b.st[0], nx = b.st[1];
        if (nloc == 0u) { xcd_barrier_complete(bar, bx, nloc, nx); b.st[0] = nloc; b.st[1] = nx; }
        const unsigned old = xb_add(&bar[XB_XSUB(bx)], 1u);
        const unsigned gen = old / nloc;
        if (old + 1u == (gen + 1u) * nloc) {
            __builtin_amdgcn_fence(__ATOMIC_RELEASE, "agent");
            asm volatile("s_waitcnt vmcnt(0)" ::: "memory");
            const unsigned og = xb_add(&bar[XB_TOP], 1u);
            const unsigned tg = og / nx;
            if (og + 1u == (tg + 1u) * nx) xb_add(&bar[XB_TOPGEN], 1u);
            else XB_SPIN(xb_ld(&bar[XB_TOPGEN]) == tg, bar);
            __builtin_amdgcn_fence(__ATOMIC_ACQUIRE, "agent");
            xb_add(&bar[XB_XGEN(bx)], 1u);
            asm volatile("s_waitcnt vmcnt(0)" ::: "memory");
        } else {
            XB_SPIN(xb_ld(&bar[XB_XGEN(bx)]) == gen, bar);
            __builtin_amdgcn_fence(__ATOMIC_ACQUIRE, "agent");
            asm volatile("s_waitcnt vmcnt(0)" ::: "memory");
        }
    }
    __syncthreads();
}

struct Frame {
    LAS unsigned char* lds;
    int tid, lane, wave, vcu, G;
    const float *x, *norm_pre, *norm_post, *w_in, *b_i, *b_f, *head_norm, *conv_w, *conv_norm, *w_out;
    float* out;
    unsigned char* ws;
};

__host__ __device__ __forceinline__ int rho_plain(int ci) {
    const int wc = ci >> 6, bj = (ci >> 5) & 1, fq = (ci >> 3) & 3, n = (ci >> 2) & 1, e = ci & 3;
    return 128 * bj + 32 * wc + 16 * n + 4 * fq + e;
}
__host__ __device__ __forceinline__ int dest1(int cc) {
    if (cc < 2048) return (cc & ~255) + rho_plain(cc & 255);
    if (cc < 4096) { const int qn = (cc - 2048) >> 10, ch = cc & 1023, gt = ch >> 7, c = ch & 127;
        const int wc = c >> 5, fq = (c >> 3) & 3, bj = (c >> 2) & 1, e = c & 3;
        return 256 * (8 + gt) + 128 * bj + 32 * wc + 16 * qn + 4 * fq + e; }
    { const int qn = (cc - 4096) >> 10, ch = cc & 1023, g = ch >> 6, c = ch & 63;
      const int wc = c >> 4, fq = ((c >> 3) & 1) | (((c >> 2) & 1) << 1), e = c & 3, bj = qn >> 1, n = qn & 1;
      return 256 * (16 + g) + 128 * bj + 32 * wc + 16 * n + 4 * fq + e; }
}

struct PrepItem { const float* W; const float* gk; bf16* WT; int ldw, k0, src, cc0, Kd, which; float cscale; };
__device__ __forceinline__ PrepItem prep_item(const Frame& F, int it) {
    constexpr int I1 = 16 * 256, I2 = 32 * 32;
    const int l = it / (I1 + I2); int r = it % (I1 + I2); PrepItem p;
    if (r < I1) { const int kb = r >> 8, cb = r & 255, cc0 = cb * 32;
        p.W = F.w_in + (size_t)l * D * INCOLS; p.ldw = INCOLS; p.k0 = kb * 64; p.src = cc0 < 4096 ? cc0 : cc0 + 8; p.cc0 = cc0; p.gk = F.norm_pre + l * D; p.cscale = cc0 < 512 ? 0.08838834764831845f : ((cc0 >= 2048 && cc0 < 4096) || cc0 >= 7168) ? -1.4426950408889634f : 1.0f;
        p.WT = (bf16*)(F.ws + WS_BT1) + (size_t)l * N1 * D; p.Kd = D; p.which = 0;
    } else { r -= I1; const int kb = r >> 5, cb = r & 31;
        p.W = F.w_out + (size_t)l * DMIX * D; p.ldw = D; p.k0 = kb * 64; p.src = cb * 32; p.cc0 = cb * 32; p.gk = F.norm_pre; p.cscale = 1.0f;
        p.WT = (bf16*)(F.ws + WS_BT2) + (size_t)l * D * DMIX; p.Kd = DMIX; p.which = 1; }
    return p;
}
__device__ __forceinline__ void prep_load(const PrepItem& p, f32x4 (&ld)[8], int lane) {
#pragma unroll
    for (int i = 0; i < 8; ++i) ld[i] = *(const GAS f32x4*)(p.W + (size_t)(p.k0 + 8 * i + (lane >> 3)) * p.ldw + p.src + 4 * (lane & 7));
}
__device__ __forceinline__ void prep_finish(const PrepItem& p, const f32x4 (&ld)[8], LAS float* scr, int lane) {
#pragma unroll
    for (int i = 0; i < 8; ++i) { const int kk = 8 * i + (lane >> 3); f32x4 v = ld[i];
        if (p.which == 0) v = v * (p.gk[p.k0 + kk] * p.cscale);
        LAS float* d = scr + kk * 33 + 4 * (lane & 7); d[0] = v.x; d[1] = v.y; d[2] = v.z; d[3] = v.w; }
    LDS_WAIT(); asm volatile("" ::: "memory");
    const int c = lane & 7;
#pragma unroll
    for (int j = 0; j < 4; ++j) { const int n = (lane >> 3) + 8 * j; const LAS float* s = scr + (8 * c) * 33 + n;
        v4u o; o.x = cvt_pk_bf16(s[0 * 33], s[1 * 33]); o.y = cvt_pk_bf16(s[2 * 33], s[3 * 33]); o.z = cvt_pk_bf16(s[4 * 33], s[5 * 33]); o.w = cvt_pk_bf16(s[6 * 33], s[7 * 33]);
        const int cc = p.cc0 + n; const int row = (p.which == 0) ? dest1(cc) : ((cc & ~255) + rho_plain(cc & 255));
        *(GAS v4u*)(p.WT + (size_t)row * p.Kd + p.k0 + 8 * c) = o; }
    LDS_WAIT(); asm volatile("" ::: "memory");
}
__device__ __forceinline__ void prep_phase(Frame& F) {
    LAS float* scr = (LAS float*)(F.lds + F.wave * 16384);
    const int gw = F.vcu * NWAVES + F.wave, NGW = F.G * NWAVES;
    constexpr int NIT = DEPTH * (16 * 256 + 32 * 32);
    f32x4 la[8], lb[8]; PrepItem pa, pb;
    int it = gw;
    if (it < NIT) { pa = prep_item(F, it); prep_load(pa, la, F.lane); }
    for (; it < NIT; it += 2 * NGW) {
        const bool hb = it + NGW < NIT;
        if (hb) { pb = prep_item(F, it + NGW); prep_load(pb, lb, F.lane); }
        prep_finish(pa, la, scr, F.lane);
        if (hb) {
            if (it + 2 * NGW < NIT) { pa = prep_item(F, it + 2 * NGW); prep_load(pa, la, F.lane); }
            prep_finish(pb, lb, scr, F.lane);
        }
    }
    float* wg = (float*)(F.ws + WS_WG);
    for (int i = (F.vcu * NWAVES + F.wave) * 64 + F.lane; i < DEPTH * 8 * D; i += F.G * NWAVES * 64) {
        const int l = i / (8 * D), j = (i / D) & 7, k = i % D;
        wg[i] = F.w_in[(size_t)l * D * INCOLS + (size_t)k * INCOLS + 4096 + j] * F.norm_pre[l * D + k];
    }
}

#define DPP_ADD(v, ctrl) ((v) + __int_as_float(__builtin_amdgcn_update_dpp(0, __float_as_int(v), (ctrl), 0xf, 0xf, false)))
__device__ __forceinline__ float row_sum16(float v) { v = DPP_ADD(v, 0xB1); v = DPP_ADD(v, 0x4E); v = DPP_ADD(v, 0x124); v = DPP_ADD(v, 0x128); return v; }
__device__ __forceinline__ float wave_sum2(float v) { v = row_sum16(v); v = xadd32(xadd16(v)); return v; }
typedef __bf16 bf16x2_t __attribute__((ext_vector_type(2)));
__device__ __forceinline__ float dot2bf(unsigned a, unsigned b, float acc) { return __builtin_amdgcn_fdot2_f32_bf16(__builtin_bit_cast(bf16x2_t, a), __builtin_bit_cast(bf16x2_t, b), acc, false); }
__device__ __forceinline__ float dpp_x1(float v) { return __int_as_float(__builtin_amdgcn_update_dpp(0, __float_as_int(v), 0xB1, 0xf, 0xf, false)); }
__device__ __forceinline__ float dpp_x2(float v) { return __int_as_float(__builtin_amdgcn_update_dpp(0, __float_as_int(v), 0x4E, 0xf, 0xf, false)); }
constexpr int TNR = 2;
struct ThinCtx { const float* x; bf16* XB; const bf16* OUTB; float* out; float* RSTD; float* LI; float* LF; LAS float* wgl; int l, lane; bool wn; float bi, bfv; };
__device__ __forceinline__ void thin_load(const ThinCtx& c, v4u (&raw)[TNR][4], float (&rsd)[TNR], const size_t m0, const size_t mstep) {
#pragma unroll
    for (int r = 0; r < TNR; ++r) { const size_t m = m0 + (size_t)r * mstep;
        rsd[r] = 1.0f;
        if (c.l == 0) {
#pragma unroll
            for (int q = 0; q < 4; ++q) raw[r][q] = *(const GAS v4u*)(c.x + m * D + 256 * q + 4 * c.lane);
        } else {
            rsd[r] = c.RSTD[m];
#pragma unroll
            for (int q = 0; q < 4; ++q) { const v2u a = *(const GAS v2u*)(c.XB + m * D + 256 * q + 4 * c.lane), b = *(const GAS v2u*)(c.OUTB + m * D + 256 * q + 4 * c.lane);
                raw[r][q] = (v4u){a.x, a.y, b.x, b.y}; }
        } }
}
__device__ __forceinline__ void thin_rows(const ThinCtx& c, const v4u (&raw)[TNR][4], const float (&rsd)[TNR], const f32x4 (&gp)[4], const size_t m0, const size_t mstep) {
    const int lane = c.lane;
#pragma unroll
    for (int r = 0; r < TNR; ++r) { const size_t m = m0 + (size_t)r * mstep;
        f32x4 v[4];
        if (c.l == 0) {
#pragma unroll
            for (int q = 0; q < 4; ++q) v[q] = __builtin_bit_cast(f32x4, raw[r][q]);
        } else {
            f32x4 o[4]; float ss = 0.f;
            const float unr = 1.0f / rsd[r];
#pragma unroll
            for (int q = 0; q < 4; ++q) { const v4u w = raw[r][q]; v[q] = (f32x4){bf_lo(w.x), bf_hi(w.x), bf_lo(w.y), bf_hi(w.y)} * unr;
                o[q] = (f32x4){bf_lo(w.z), bf_hi(w.z), bf_lo(w.w), bf_hi(w.w)}; ss += (o[q].x * o[q].x + o[q].y * o[q].y) + (o[q].z * o[q].z + o[q].w * o[q].w); }
            const float rs = rsqrtf(wave_sum2(ss) * (1.0f / D) + EPS);
#pragma unroll
            for (int q = 0; q < 4; ++q) { v[q] = v[q] + o[q] * rs * gp[q]; if (!c.wn) *(GAS f32x4*)(c.out + m * D + 256 * q + 4 * lane) = v[q]; }
        }
        if (c.wn) {
            float ss = 0.f;
#pragma unroll
            for (int q = 0; q < 4; ++q) ss += (v[q].x * v[q].x + v[q].y * v[q].y) + (v[q].z * v[q].z + v[q].w * v[q].w);
            ss = row_sum16(ss); ss = xadd32(xadd16(ss));
            const float rstd = rsqrtf(ss * (1.0f / D) + EPS);
            unsigned xw[8];
#pragma unroll
            for (int q = 0; q < 4; ++q) { const f32x4 vn = v[q] * rstd; xw[2 * q] = cvt_pk_bf16(vn.x, vn.y); xw[2 * q + 1] = cvt_pk_bf16(vn.z, vn.w);
                *(GAS v2u*)(c.XB + m * D + 256 * q + 4 * lane) = (v2u){xw[2 * q], xw[2 * q + 1]}; }
            if (lane == 0) c.RSTD[m] = rstd;
            float a[8];
#pragma unroll
            for (int j = 0; j < 8; ++j) { const v4u w0 = *(const LAS v4u*)((LAS unsigned*)c.wgl + (j * 64 + lane) * 8), w1 = *(const LAS v4u*)((LAS unsigned*)c.wgl + (j * 64 + lane) * 8 + 4);
                float s = 0.f;
                s = dot2bf(xw[0], w0.x, s); s = dot2bf(xw[1], w0.y, s); s = dot2bf(xw[2], w0.z, s); s = dot2bf(xw[3], w0.w, s);
                s = dot2bf(xw[4], w1.x, s); s = dot2bf(xw[5], w1.y, s); s = dot2bf(xw[6], w1.z, s); s = dot2bf(xw[7], w1.w, s);
                a[j] = s; }
            const bool o1 = lane & 1, o2 = lane & 2;
            float b4[4];
#pragma unroll
            for (int i = 0; i < 4; ++i) { const float keep = o1 ? a[2 * i + 1] : a[2 * i], send = o1 ? a[2 * i] : a[2 * i + 1]; b4[i] = keep + dpp_x1(send); }
            float c2[2];
#pragma unroll
            for (int i = 0; i < 2; ++i) { const float keep = o2 ? b4[2 * i + 1] : b4[2 * i], send = o2 ? b4[2 * i] : b4[2 * i + 1]; c2[i] = keep + dpp_x2(send); }
#pragma unroll
            for (int i = 0; i < 2; ++i) { c2[i] = DPP_ADD(c2[i], 0x124); c2[i] = DPP_ADD(c2[i], 0x128); c2[i] = xadd32(xadd16(c2[i])); }
            if (lane < 4) { const int b = (int)(m >> 12), t = (int)(m & (SEQ - 1));
                const float xi = c2[0] + c.bi, xf = c2[1] + c.bfv;
                c.LI[(size_t)(b * NH + lane) * SEQ + t] = xi;
                c.LF[(size_t)(b * NH + lane) * SEQ + t] = fminf(xf, 0.f) - __logf(1.0f + __expf(-fabsf(xf))); }
        }
    }
}
__device__ __forceinline__ void thin_phase(Frame& F, const int l, const bool wn) {
    const int gw = F.vcu * NWAVES + F.wave, NGW = F.G * NWAVES, lane = F.lane;
    ThinCtx c; c.x = F.x; c.XB = (bf16*)(F.ws + WS_XB); c.OUTB = (const bf16*)(F.ws + WS_OUT); c.out = F.out; c.RSTD = (float*)(F.ws + WS_RSTD);
    c.LI = (float*)(F.ws + WS_LI); c.LF = (float*)(F.ws + WS_LF); c.wgl = (LAS float*)F.lds; c.l = l; c.lane = lane; c.wn = wn; c.bi = 0.f; c.bfv = 0.f;
    if (wn) {
        const float* wgp = (const float*)(F.ws + WS_WG) + (size_t)l * 8 * D;
#pragma unroll
        for (int i = 0; i < 4; ++i) { const int idx = F.tid + 512 * i, j = idx >> 8, k4 = idx & 255, q = k4 >> 6, ln = k4 & 63;
            f32x4 wv;
            if (l == 0) { const float* wc0 = F.w_in + (size_t)(4 * k4) * INCOLS + 4096 + j; const f32x4 gpre = *(const GAS f32x4*)(F.norm_pre + 4 * k4);
                wv = (f32x4){wc0[0] * gpre.x, wc0[INCOLS] * gpre.y, wc0[2 * INCOLS] * gpre.z, wc0[3 * INCOLS] * gpre.w}; }
            else wv = *(const GAS f32x4*)(wgp + j * D + 4 * k4);
            v2u pk; pk.x = cvt_pk_bf16(wv.x, wv.y); pk.y = cvt_pk_bf16(wv.z, wv.w);
            *(LAS v2u*)((LAS unsigned*)c.wgl + (j * 64 + ln) * 8 + 2 * q) = pk; }
        c.bi = F.b_i[l * NH + (lane & 3)]; c.bfv = F.b_f[l * NH + (lane & 3)];
    }
    __syncthreads();
    f32x4 gp[4];
#pragma unroll
    for (int q = 0; q < 4; ++q) gp[q] = (f32x4){0.f, 0.f, 0.f, 0.f};
    if (l > 0) {
#pragma unroll
        for (int q = 0; q < 4; ++q) gp[q] = *(const GAS f32x4*)(F.norm_post + (l - 1) * D + 256 * q + 4 * lane);
    }
    const size_t step = (size_t)NGW, trip = TNR * (size_t)NGW;
    v4u ra[TNR][4], rb[TNR][4]; float sa[TNR], sb[TNR];
    size_t m0 = (size_t)gw;
    thin_load(c, ra, sa, m0, step);
    for (; m0 < (size_t)MTOK; m0 += 2 * trip) {
        if (m0 + trip < (size_t)MTOK) thin_load(c, rb, sb, m0 + trip, step);
        thin_rows(c, ra, sa, gp, m0, step);
        if (m0 + trip < (size_t)MTOK) {
            if (m0 + 2 * trip < (size_t)MTOK) thin_load(c, ra, sa, m0 + 2 * trip, step);
            thin_rows(c, rb, sb, gp, m0 + trip, step);
        }
    }
    __syncthreads();
}

__device__ __forceinline__ unsigned dppx1u(unsigned v) { return (unsigned)__builtin_amdgcn_update_dpp(0, (int)v, 0xB1, 0xf, 0xf, false); }
template <bool SKIPPABLE>
__device__ __forceinline__ void store_plain_tile(const pg8::f32x4 (&acc)[2][2][4][2], bf16* base, size_t ld, int row0, int col0, int fr, int fq, bool skip) {
    const bool odd = fr & 1;
#pragma unroll
    for (int ai = 0; ai < 2; ++ai)
#pragma unroll
        for (int m = 0; m < 4; ++m) {
            v4u a[2];
#pragma unroll
            for (int bj = 0; bj < 2; ++bj) { const f32x4 v0 = acc[ai][bj][m][0], v1 = acc[ai][bj][m][1];
                a[bj].x = cvt_pk_bf16(v0[0], v0[1]); a[bj].y = cvt_pk_bf16(v0[2], v0[3]); a[bj].z = cvt_pk_bf16(v1[0], v1[1]); a[bj].w = cvt_pk_bf16(v1[2], v1[3]); }
            v4u de, dq;
            asm volatile("s_nop 1\n\ts_mov_b32 vcc_lo, 0x55555555\n\ts_mov_b32 vcc_hi, 0x55555555\n\t"
                         "v_cndmask_b32_dpp %0, %8, %12, vcc quad_perm:[1,0,3,2] row_mask:0xf bank_mask:0xf\n\tv_cndmask_b32_dpp %1, %9, %13, vcc quad_perm:[1,0,3,2] row_mask:0xf bank_mask:0xf\n\t"
                         "v_cndmask_b32_dpp %2, %10, %14, vcc quad_perm:[1,0,3,2] row_mask:0xf bank_mask:0xf\n\tv_cndmask_b32_dpp %3, %11, %15, vcc quad_perm:[1,0,3,2] row_mask:0xf bank_mask:0xf\n\t"
                         "s_not_b64 vcc, vcc\n\t"
                         "v_cndmask_b32_dpp %4, %12, %8, vcc quad_perm:[1,0,3,2] row_mask:0xf bank_mask:0xf\n\tv_cndmask_b32_dpp %5, %13, %9, vcc quad_perm:[1,0,3,2] row_mask:0xf bank_mask:0xf\n\t"
                         "v_cndmask_b32_dpp %6, %14, %10, vcc quad_perm:[1,0,3,2] row_mask:0xf bank_mask:0xf\n\tv_cndmask_b32_dpp %7, %15, %11, vcc quad_perm:[1,0,3,2] row_mask:0xf bank_mask:0xf"
                         : "=&v"(de.x), "=&v"(de.y), "=&v"(de.z), "=&v"(de.w), "=&v"(dq.x), "=&v"(dq.y), "=&v"(dq.z), "=&v"(dq.w)
                         : "v"(a[1].x), "v"(a[1].y), "v"(a[1].z), "v"(a[1].w), "v"(a[0].x), "v"(a[0].y), "v"(a[0].z), "v"(a[0].w) : "vcc", "scc");
            const int r = row0 + ai * 128 + m * 16;
            bf16* pe = base + (size_t)(r & ~1) * ld + col0 + (odd ? 32 : 0) + 8 * fq;
            bf16* po = base + (size_t)(r | 1) * ld + col0 + (odd ? 32 : 0) + 8 * fq;
            if (!SKIPPABLE || !skip) { *(GAS v4u*)pe = de; *(GAS v4u*)po = dq; }
        }
}
#ifdef PROBE
#define EPI_ST(stmt) { if (!skipst) { stmt } }
#else
#define EPI_ST(stmt) { stmt }
#endif
#ifdef USE_NT
#define NT_ST(p, v) __builtin_nontemporal_store((v), (p))
#else
#define NT_ST(p, v) (*(p) = (v))
#endif
struct Epi1 {
    static constexpr bool PERM = false, AFTER_DRAIN = false;
    bf16* QKV; bf16* MIX; const float* RSTD; const LAS float* cwl; float* fix; LAS unsigned char* elds; bf16* DBGG; int mode; bool skipst;
    __device__ __forceinline__ void operator()(pg8::f32x4 (&acc)[2][2][4][2], const pg8::Unit& u, int wr, int wc, int fr, int fq) const {
        asm volatile("" : "+v"(fr), "+v"(fq));
        const int row0 = u.pm * 256 + wr * 64 + fr;
#ifdef PROBE
        if (mode == 3) {
            f32x4 s = (f32x4){0.f, 0.f, 0.f, 0.f};
#pragma unroll
            for (int ai = 0; ai < 2; ++ai)
#pragma unroll
                for (int bj = 0; bj < 2; ++bj)
#pragma unroll
                    for (int mm = 0; mm < 4; ++mm) s += acc[ai][bj][mm][0] + acc[ai][bj][mm][1];
            EPI_ST(*(GAS f32x4*)(fix + 4 * FIX_ARR + (size_t)(wr * 4 + wc) * 256 + (fq * 16 + fr) * 4) = s;)
            return; }
        if (mode == 2 || u.pn < 8) {
#else
        if (u.pn < 8) {
#endif
#ifdef PROBE
            store_plain_tile<true>(acc, QKV, 2048, row0, (u.pn & 7) * 256 + 64 * wc, fr, fq, skipst);
#else
            store_plain_tile<false>(acc, QKV, 2048, row0, (u.pn & 7) * 256 + 64 * wc, fr, fq, false);
#endif
        } else if (u.pn < 16) {
#pragma unroll
            for (int ai = 0; ai < 2; ++ai)
#pragma unroll
                for (int m = 0; m < 4; ++m) { const int r = row0 + ai * 128 + m * 16;
                    f32x4 g[2];
#pragma unroll
                    for (int bj = 0; bj < 2; ++bj) { const f32x4 os = acc[ai][bj][m][0], zs = acc[ai][bj][m][1]; f32x4 a, b, r;
#pragma unroll
                        for (int e = 0; e < 4; ++e) { a[e] = __builtin_amdgcn_exp2f(zs[e]); b[e] = __builtin_amdgcn_exp2f(os[e]); }
                        const f32x4 d = (a * -1.4426950408889634f + -1.4426950408889634f) * (b + 1.0f);
#pragma unroll
                        for (int e = 0; e < 4; ++e) r[e] = __builtin_amdgcn_rcpf(d[e]);
                        g[bj] = zs * r; }
                    v4u w; w.x = cvt_pk_bf16(g[0][0], g[0][1]); w.y = cvt_pk_bf16(g[0][2], g[0][3]); w.z = cvt_pk_bf16(g[1][0], g[1][1]); w.w = cvt_pk_bf16(g[1][2], g[1][3]);
                    EPI_ST(NT_ST((v4u*)(MIX + (size_t)r * 2048 + (u.pn - 8) * 128 + 32 * wc + 8 * fq), w);)
#ifdef DBG
                    EPI_ST(*(GAS v4u*)(DBGG + (size_t)r * 1024 + (u.pn - 8) * 128 + 32 * wc + 8 * fq) = w;)
#endif
                    }
        } else {
            const int g = u.pn - 16, ch0 = 64 * g + 16 * wc + 8 * (fq & 1) + 4 * (fq >> 1);
            LAS float* halo = (LAS float*)elds;
            LAS float* part = (LAS float*)(elds + 2048);
            float* cuL = fix; float* cuF = fix + FIX_ARR; float* bF = fix + 2 * FIX_ARR; float* zF = fix + 3 * FIX_ARR;
#pragma unroll
            for (int ai = 0; ai < 2; ++ai)
#pragma unroll
                for (int m = 0; m < 4; ++m) acc[ai][0][m][0] = acc[ai][0][m][0] * acc[ai][1][m][0];
#pragma unroll
            for (int ai = 0; ai < 2; ++ai) {
                if (fr >= 14) { *(LAS f32x4*)(halo + ((2 * ai + wr) * 2 + (fr - 14)) * 64 + 16 * wc + 4 * fq) = acc[ai][0][3][0];
                    if (ai == 1 && wr == 1) EPI_ST(*(GAS f32x4*)(cuL + ((size_t)u.pm * 2 + (fr - 14)) * 1024 + ch0) = acc[1][0][3][0];) }
            }
            if (wr == 0 && fr < 2) { const size_t o = ((size_t)u.pm * 2 + fr) * 1024 + ch0;
                EPI_ST(*(GAS f32x4*)(cuF + o) = acc[0][0][0][0];) EPI_ST(*(GAS f32x4*)(bF + o) = acc[0][0][0][1];) EPI_ST(*(GAS f32x4*)(zF + o) = acc[0][1][0][1];) }
            LDS_WAIT(); __builtin_amdgcn_s_barrier(); asm volatile("" ::: "memory");
            const f32x4 w0 = *(const LAS f32x4*)(cwl + ch0), w1 = *(const LAS f32x4*)(cwl + 1024 + ch0), w2 = *(const LAS f32x4*)(cwl + 2048 + ch0);
#pragma unroll
            for (int ai = 0; ai < 2; ++ai) {
                const int blk = 2 * ai + wr;
                f32x4 p1 = (f32x4){0.f, 0.f, 0.f, 0.f}, p2 = p1;
                if (blk > 0) { p1 = *(const LAS f32x4*)(halo + ((blk - 1) * 2 + 1) * 64 + 16 * wc + 4 * fq); p2 = *(const LAS f32x4*)(halo + ((blk - 1) * 2 + (fr & 1)) * 64 + 16 * wc + 4 * fq); }
#pragma unroll
                for (int m = 0; m < 4; ++m) {
                    const f32x4 cu = acc[ai][0][m][0]; f32x4 s1, s2, a1, a2;
#pragma unroll
                    for (int e = 0; e < 4; ++e) { a1[e] = dpp_shr1(p1[e], cu[e]); a2[e] = dpp_shr2(p2[e], cu[e]);
                        if (m < 3) { s1[e] = dpp_ror1(cu[e]); s2[e] = dpp_ror2(cu[e]); } else { s1[e] = 0.f; s2[e] = 0.f; } }
                    const f32x4 cv = w2 * cu + w1 * a1 + w0 * a2;
                    const f32x4 bc = acc[ai][0][m][1] * cv;
                    acc[ai][1][m][0] = bc;
                    float ss = (bc[0] * bc[0] + bc[1] * bc[1]) + (bc[2] * bc[2] + bc[3] * bc[3]);
                    ss = xadd32(xadd16(ss));
                    if (fq == 0) part[(128 * ai + 64 * wr + 16 * m + fr) * 4 + wc] = ss;
                    p1 = s1; p2 = s2;
                }
            }
            LDS_WAIT(); __builtin_amdgcn_s_barrier(); asm volatile("" ::: "memory");
            const f32x4 gc = *(const LAS f32x4*)(cwl + 3072 + ch0);
#pragma unroll
            for (int ai = 0; ai < 2; ++ai)
#pragma unroll
                for (int mp = 0; mp < 2; ++mp) {
                    v2u wq[2];
#pragma unroll
                    for (int mo = 0; mo < 2; ++mo) { const int m = 2 * mp + mo, rt = 128 * ai + 64 * wr + 16 * m + fr;
                        const f32x4 ps = *(const LAS f32x4*)(part + rt * 4);
                        const float rg = __builtin_amdgcn_rsqf(((ps[0] + ps[1]) + (ps[2] + ps[3])) * (1.0f / 64.0f) + EPS);
                        const f32x4 zs = acc[ai][1][m][1], bc = acc[ai][1][m][0]; f32x4 a, r;
#pragma unroll
                        for (int e = 0; e < 4; ++e) a[e] = __builtin_amdgcn_exp2f(zs[e]);
                        a = a + 1.0f;
#pragma unroll
                        for (int e = 0; e < 4; ++e) r[e] = __builtin_amdgcn_rcpf(a[e]);
                        const f32x4 y = (zs * r) * (bc * (gc * rg));
                        wq[mo].x = cvt_pk_bf16(y[0], y[1]); wq[mo].y = cvt_pk_bf16(y[2], y[3]); }
                    const auto sx = __builtin_amdgcn_permlane32_swap(wq[0].x, wq[1].x, false, false), sy = __builtin_amdgcn_permlane32_swap(wq[0].y, wq[1].y, false, false);
                    v4u w; w.x = sx[0]; w.y = sy[0]; w.z = sx[1]; w.w = sy[1];
                    const int rt = 128 * ai + 64 * wr + 16 * (2 * mp + (fq >> 1)) + fr;
                    EPI_ST(*(GAS v4u*)(MIX + (size_t)(u.pm * 256 + rt) * 2048 + 1024 + 64 * g + 16 * wc + 8 * (fq & 1)) = w;) }
        }
    }
};
struct Order1 {
    pg8::StaticOrder sc, sg, sq, sall; int rc, rg; bool sweeps;
    __device__ void init(int G_, int c_) { sc.init(MTOK, 4096, G_, c_); sg.init(MTOK, 2048, G_, c_); sq.init(MTOK, 2048, G_, c_); sall.init(MTOK, N1, G_, c_);
        rc = sc.nwg / G_; rg = sg.nwg / G_; sweeps = (sc.nwg % G_ == 0) && (sg.nwg % G_ == 0); }
    __device__ bool next(int i, pg8::Unit& u) const {
        if (!sweeps) return sall.next(i, u);
        if (i < rc) { sc.next(i, u); u.pn += 16; return true; }
#ifdef ORDER_QKV_BEFORE_GATE
        if (i < rc + rg) { sq.next(i - rc, u); return true; }
        if (i < rc + 2 * rg) { sg.next(i - rc - rg, u); u.pn += 8; return true; }
#else
        if (i < rc + rg) { sg.next(i - rc, u); u.pn += 8; return true; }
        if (i < rc + 2 * rg) { sq.next(i - rc - rg, u); return true; }
#endif
        return false;
    }
    __device__ __forceinline__ void a_ready(const pg8::Unit&) const {}
    __device__ __forceinline__ void done(const pg8::Unit&) const {}
};
struct Epi2 {
    static constexpr bool PERM = false, AFTER_DRAIN = false;
    bf16* O;
    __device__ __forceinline__ void operator()(pg8::f32x4 (&acc)[2][2][4][2], const pg8::Unit& u, int wr, int wc, int fr, int fq) const {
        const int row0 = u.pm * 256 + wr * 64 + fr;
        store_plain_tile<false>(acc, O, 1024, row0, u.pn * 256 + 64 * wc, fr, fq, false);
    }
};

__device__ __forceinline__ void conv_fixup(Frame& F, const int l) {
    const float* fix = (const float*)(F.ws + WS_FIX);
    const float *cuL = fix, *cuF = fix + FIX_ARR, *bF = fix + 2 * FIX_ARR, *zF = fix + 3 * FIX_ARR;
    const float* cw = F.conv_w + (size_t)l * 3 * DCONV; const float* cg = F.conv_norm + (size_t)l * DCONV;
    bf16* MIX = (bf16*)(F.ws + WS_MIX);
    const int gw = F.vcu * NWAVES + F.wave, NGW = F.G * NWAVES, lane = F.lane;
    for (int it0 = gw; it0 < 256 * 2 * 16; it0 += 4 * NGW) {
        float c0[4], c1[4], pl0[4], pl1[4], bb[4], zz[4], w0[4], w1[4], w2[4], gg[4];
#pragma unroll
        for (int k = 0; k < 4; ++k) { const int it = it0 + k * NGW, pm = (it >> 5) & 255, rr = (it >> 4) & 1, g = it & 15, ch = 64 * g + lane, pmp = pm > 0 ? pm - 1 : 0;
            c0[k] = cuF[((size_t)pm * 2 + 0) * 1024 + ch]; c1[k] = cuF[((size_t)pm * 2 + 1) * 1024 + ch];
            pl0[k] = cuL[((size_t)pmp * 2 + 0) * 1024 + ch]; pl1[k] = cuL[((size_t)pmp * 2 + 1) * 1024 + ch];
            bb[k] = bF[((size_t)pm * 2 + rr) * 1024 + ch]; zz[k] = zF[((size_t)pm * 2 + rr) * 1024 + ch];
            w0[k] = cw[ch]; w1[k] = cw[1024 + ch]; w2[k] = cw[2048 + ch]; gg[k] = cg[ch]; }
#pragma unroll
        for (int k = 0; k < 4; ++k) { const int it = it0 + k * NGW, pm = it >> 5, rr = (it >> 4) & 1, g = it & 15, ch = 64 * g + lane;
            if (it >= 256 * 2 * 16 || (pm & 15) == 0) continue;
            const float cv = rr == 0 ? (w2[k] * c0[k] + w1[k] * pl1[k] + w0[k] * pl0[k]) : (w2[k] * c1[k] + w1[k] * c0[k] + w0[k] * pl1[k]);
            const float bc = bb[k] * cv;
            const float rg = rsqrtf(wave_sum(bc * bc) * (1.0f / 64.0f) + EPS);
            const float z = zz[k] * -0.6931471805599453f;
            const float y = z * sigmoidf_(z) * bc * rg * gg[k];
            MIX[(size_t)(pm * 256 + rr) * 2048 + 1024 + ch] = (bf16)(cvt_pk_bf16(y, y) & 0xffffu); }
    }
}

namespace ml {
#ifndef MC_ABL
#define MC_ABL 0
#endif
template <bool PASSC> struct Lay;
template <> struct Lay<true>  { static constexpr int NBUF = 2, BUFB = 65536, Q = 0, K = 16384, V = 32768, SC = 139264, SW = 3072, SM = 4096; };
template <> struct Lay<false> { static constexpr int NBUF = 3, BUFB = 49152, Q = 0, K = 0, V = 16384, SC = 147456, SW = 0, SM = 1024; };
constexpr int L_P = 131072;
constexpr int SP = 0, SMM = 1024, SB = 2048;
constexpr int RSP = 0, QN = 128, HN = 192, NV = 704, DEC = 832, MST = 848, BLS = 868, CML = 884;
static_assert(Lay<true>::SC + (Lay<true>::SM + 900) * 4 <= MISC_OFF && Lay<false>::SC + (Lay<false>::SM + 900) * 4 <= MISC_OFF && Lay<false>::NBUF * Lay<false>::BUFB <= Lay<false>::SC, "mLSTM LDS map");
__device__ __forceinline__ unsigned swz(unsigned row) { return ((row & 3) << 2) | ((row >> 2) & 3); }
__device__ __forceinline__ unsigned off_b(unsigned row, unsigned ch) { return 256u * row + 16u * (ch ^ swz(row)); }
__device__ __forceinline__ unsigned tr_addr16(unsigned lane, unsigned c, unsigned ks, unsigned t) {
    const unsigned g = lane >> 4, q = (lane & 15) >> 2, p = lane & 3;
    return off_b(32 * ks + 8 * g + 4 * t + q, 2 * c + (p >> 1)) + 8 * (p & 1);
}
__device__ __forceinline__ unsigned tr_addr16v(unsigned lane, unsigned c, unsigned ks, unsigned t) {
    const unsigned g = lane >> 4, q = (lane & 15) >> 2, p0 = lane & 3, p = ((p0 & 1) << 1) | (p0 >> 1);
    return off_b(32 * ks + 8 * g + 4 * t + q, 2 * c + (p >> 1)) + 8 * (p & 1);
}
__device__ __forceinline__ void tr_read8(s16x4 (&o)[8], const unsigned (&a)[8]) {
    asm volatile("ds_read_b64_tr_b16 %0, %8\n\tds_read_b64_tr_b16 %1, %9\n\tds_read_b64_tr_b16 %2, %10\n\tds_read_b64_tr_b16 %3, %11\n\t"
                 "ds_read_b64_tr_b16 %4, %12\n\tds_read_b64_tr_b16 %5, %13\n\tds_read_b64_tr_b16 %6, %14\n\tds_read_b64_tr_b16 %7, %15\n\ts_waitcnt lgkmcnt(0)"
                 : "=&v"(o[0]), "=&v"(o[1]), "=&v"(o[2]), "=&v"(o[3]), "=&v"(o[4]), "=&v"(o[5]), "=&v"(o[6]), "=&v"(o[7])
                 : "v"(a[0]), "v"(a[1]), "v"(a[2]), "v"(a[3]), "v"(a[4]), "v"(a[5]), "v"(a[6]), "v"(a[7]) : "memory");
}
template <int O0, int O1, int O2, int O3, int O4, int O5, int O6, int O7>
__device__ __forceinline__ void tr_read8o(s16x4 (&o)[8], unsigned a0, unsigned a1, unsigned a2, unsigned a3, unsigned a4, unsigned a5, unsigned a6, unsigned a7) {
    asm volatile("ds_read_b64_tr_b16 %0, %8 offset:%16\n\tds_read_b64_tr_b16 %1, %9 offset:%17\n\tds_read_b64_tr_b16 %2, %10 offset:%18\n\tds_read_b64_tr_b16 %3, %11 offset:%19\n\t"
                 "ds_read_b64_tr_b16 %4, %12 offset:%20\n\tds_read_b64_tr_b16 %5, %13 offset:%21\n\tds_read_b64_tr_b16 %6, %14 offset:%22\n\tds_read_b64_tr_b16 %7, %15 offset:%23\n\ts_waitcnt lgkmcnt(0)"
                 : "=&v"(o[0]), "=&v"(o[1]), "=&v"(o[2]), "=&v"(o[3]), "=&v"(o[4]), "=&v"(o[5]), "=&v"(o[6]), "=&v"(o[7])
                 : "v"(a0), "v"(a1), "v"(a2), "v"(a3), "v"(a4), "v"(a5), "v"(a6), "v"(a7), "i"(O0), "i"(O1), "i"(O2), "i"(O3), "i"(O4), "i"(O5), "i"(O6), "i"(O7) : "memory");
}
__device__ __forceinline__ unsigned lds_u32(const LAS unsigned char* p) { return (unsigned)(unsigned long)p; }
__device__ __forceinline__ bf16x8 cat8(s16x4 a, s16x4 b) { return (bf16x8){a[0], a[1], a[2], a[3], b[0], b[1], b[2], b[3]}; }
__device__ __forceinline__ bf16x8 pack8(const f32x4 a, const f32x4 b) {
    const unsigned x = cvt_pk_bf16(a[0], a[1]), y = cvt_pk_bf16(a[2], a[3]), z = cvt_pk_bf16(b[0], b[1]), w = cvt_pk_bf16(b[2], b[3]);
    return __builtin_bit_cast(bf16x8, (v4u){x, y, z, w});
}
__device__ __forceinline__ bf16x8 scale8(const bf16x8 v, const f32x4 s0, const f32x4 s1) {
    const v4u u = __builtin_bit_cast(v4u, v);
    const unsigned x = cvt_pk_bf16(bf_lo(u.x) * s0[0], bf_hi(u.x) * s0[1]), y = cvt_pk_bf16(bf_lo(u.y) * s0[2], bf_hi(u.y) * s0[3]);
    const unsigned z = cvt_pk_bf16(bf_lo(u.z) * s1[0], bf_hi(u.z) * s1[1]), w = cvt_pk_bf16(bf_lo(u.w) * s1[2], bf_hi(u.w) * s1[3]);
    return __builtin_bit_cast(bf16x8, (v4u){x, y, z, w});
}
__device__ __forceinline__ float dot8(const bf16x8 v, const f32x4 s0, const f32x4 s1) {
    const v4u u = __builtin_bit_cast(v4u, v);
    return (bf_lo(u.x) * s0[0] + bf_hi(u.x) * s0[1]) + (bf_lo(u.y) * s0[2] + bf_hi(u.y) * s0[3]) + (bf_lo(u.z) * s1[0] + bf_hi(u.z) * s1[1]) + (bf_lo(u.w) * s1[2] + bf_hi(u.w) * s1[3]);
}
#define MFMA16(a, b, c) __builtin_amdgcn_mfma_f32_16x16x32_bf16(a, b, c, 0, 0, 0)
#define GLDS16(src, dst) __builtin_amdgcn_global_load_lds((const unsigned*)(src), (LAS unsigned*)(dst), 16, 0, 0)

template <bool PASSC>
__device__ __forceinline__ void dma_chunk(LAS unsigned char* lds, int buf, const bf16* QKV, size_t rowbase, int h, int w, int lane) {
    typedef Lay<PASSC> L;
    const int rr = lane >> 4, pos = lane & 15;
#pragma unroll
    for (int i = 0; i < 2; ++i) { const int r0 = 4 * (2 * w + i), row = r0 + rr; const unsigned sch = pos ^ swz(row);
        const bf16* src = QKV + (rowbase + row) * 2048 + h * 128 + 8 * sch;
        if (PASSC) GLDS16(src, lds + buf * L::BUFB + L::Q + 256 * r0);
        GLDS16(src + 512, lds + buf * L::BUFB + L::K + 256 * r0); }
#pragma unroll
    for (int i = 0; i < 4; ++i) { const int pc = 4 * w + i, img = pc >> 4, r0 = 4 * (pc & 15), row = r0 + rr; const unsigned sch = pos ^ swz(row);
        GLDS16(QKV + (rowbase + row) * 2048 + 1024 + h * 256 + img * 128 + 8 * sch, lds + buf * L::BUFB + L::V + img * 16384 + 256 * r0); }
}

template <bool PASSC>
__device__ __forceinline__ void dma_chunk2(LAS unsigned char* lds, int buf, const bf16* QKV, size_t rowbase, int h, int w, unsigned dq0, unsigned dv0) {
    typedef Lay<PASSC> L;
    const unsigned char* qb = (const unsigned char*)(QKV + rowbase * 2048 + h * 128);
    const unsigned char* vb = qb + h * 256;
#pragma unroll
    for (int i = 0; i < 2; ++i) { const int r0 = 4 * (2 * w + i); const unsigned o = i == 0 ? dq0 : (dq0 ^ 16u) + 16384u;
        if (PASSC) GLDS16(qb + o, lds + buf * L::BUFB + L::Q + 256 * r0);
        GLDS16(qb + o + 1024, lds + buf * L::BUFB + L::K + 256 * r0); }
#pragma unroll
    for (int i = 0; i < 4; ++i) { const int pc = 4 * w + i, img = pc >> 4, r0 = 4 * (pc & 15); const unsigned o = (dv0 ^ (unsigned)(16 * i)) + 16384u * i;
        GLDS16(vb + o, lds + buf * L::BUFB + L::V + img * 16384 + 256 * r0); }
}

template <bool PASSC>
__device__ __forceinline__ void unit(Frame& F, const int l, const int un, const int abl = 0) {
    typedef Lay<PASSC> L;
    LAS unsigned char* lds = F.lds; LAS float* sc = (LAS float*)(lds + L::SC); LAS float* sm = sc + L::SM;
    int tid0 = F.tid; asm volatile("" : "+v"(tid0)); const int w = F.wave;
    const int seg = un & (NSEG - 1), bh = un >> 2, b = bh >> 2, h = bh & 3;
    const bf16* QKV = (const bf16*)(F.ws + WS_QKV); bf16* MIX = (bf16*)(F.ws + WS_MIX); bf16* MIXO = abl ? (bf16*)(F.ws + WS_OUT) - 1024 * 0 : MIX;
    const float* LF = (const float*)(F.ws + WS_LF); const float* LI = (const float*)(F.ws + WS_LI);
    float* SEGC = (float*)(F.ws + WS_SEGC); float* SEGN = (float*)(F.ws + WS_SEGN); float* SEGS = (float*)(F.ws + WS_SEGS);
    const size_t row00 = (size_t)b * SEQ + (size_t)seg * CPS * CHUNK;
    const size_t g00 = (size_t)bh * SEQ + (size_t)seg * CPS * CHUNK;

    int tid = tid0, lane = tid0 & 63, fr = lane & 15, fq = lane >> 4;
#ifdef PROBE
#define USTAMP(i) do { if (PASSC && l == 1 && blockIdx.x == PROBE_BLK && threadIdx.x == 0) ((volatile LAS unsigned long long*)(F.lds + MISC_OFF + 64))[30 + (i)] = wall_clock64(); } while (0)
#else
#define USTAMP(i) do {} while (0)
#endif
    USTAMP(0);
    __syncthreads();
    dma_chunk<PASSC>(lds, 0, QKV, row00, h, w, lane);
    if (!PASSC) dma_chunk<PASSC>(lds, 1, QKV, row00 + CHUNK, h, w, lane);
    f32x4 C[8][2];
#pragma unroll
    for (int dt = 0; dt < 8; ++dt) { C[dt][0] = (f32x4){0.f, 0.f, 0.f, 0.f}; C[dt][1] = C[dt][0]; }
    float nreg = 0.f, m = PASSC ? 0.f : -1e30f;
    if (PASSC) {
        v4u cw[NSEG - 1][8]; float sbj[NSEG - 1], mlj[NSEG - 1], nj[NSEG - 1];
#pragma unroll
        for (int j = 0; j < NSEG - 1; ++j) if (j < seg) {
            const int uj = bh * NSEG + j; sbj[j] = SEGS[uj * 4 + 0]; mlj[j] = SEGS[uj * 4 + 1]; nj[j] = SEGN[uj * 128 + 16 * w + fr];
            const unsigned* cp = (const unsigned*)SEGC + (size_t)uj * 16384 + (size_t)w * 2048 + lane * 4;
#pragma unroll
            for (int dt = 0; dt < 8; ++dt) cw[j][dt] = *(const GAS v4u*)(cp + dt * 256); }
#pragma unroll
        for (int j = 0; j < NSEG - 1; ++j) if (j < seg) {
            const float mn = fmaxf(m + sbj[j], mlj[j]), fa = __expf(m + sbj[j] - mn), fb = __expf(mlj[j] - mn);
#pragma unroll
            for (int dt = 0; dt < 8; ++dt) { const v4u q = cw[j][dt];
                const f32x4 c0 = (f32x4){bf_lo(q.x), bf_hi(q.x), bf_lo(q.y), bf_hi(q.y)}, c1 = (f32x4){bf_lo(q.z), bf_hi(q.z), bf_lo(q.w), bf_hi(q.w)};
                C[dt][0] = C[dt][0] * fa + c0 * fb; C[dt][1] = C[dt][1] * fa + c1 * fb; }
            nreg = nreg * fa + nj[j] * fb;
            m = mn; }
        if (fq == 0) sm[NV + 16 * w + fr] = nreg;
    }
    float pj[2], cmj[2], bLj[2];
#pragma unroll
    for (int j = 0; j < 2; ++j) { const int c = 2 * w + j; const float lf = LF[g00 + c * CHUNK + lane], li = LI[g00 + c * CHUNK + lane];
        float bb = lf;
#pragma unroll
        for (int o = 1; o < 64; o <<= 1) { const float t = __shfl_up(bb, o); if (lane >= o) bb += t; }
        const float p = li - bb; float cm = p;
#pragma unroll
        for (int o = 1; o < 64; o <<= 1) { const float t = __shfl_up(cm, o); if (lane >= o) cm = fmaxf(cm, t); }
        pj[j] = p; cmj[j] = cm; bLj[j] = __shfl(bb, 63);
        if (PASSC) { sc[SP + c * 64 + lane] = p; sc[SB + c * 64 + lane] = bb; }
        if (lane == 63) { sm[BLS + c] = bb; sm[CML + c] = cm; } }
    __syncthreads();
    float sum_bL = 0.f;
    if (w == 0) {
        float mm_ = m;
        for (int c = 0; c < CPS; ++c) { const float bL = sm[BLS + c], cmL = sm[CML + c], mn = fmaxf(bL + mm_, bL + cmL);
            if (lane == 0) { sm[MST + c] = mm_; sm[DEC + c] = __expf(bL + mm_ - mn); }
            mm_ = mn; sum_bL += bL; }
        if (lane == 0) sm[MST + CPS] = mm_;
        m = mm_;
    }
    __syncthreads();
#pragma unroll
    for (int j = 0; j < 2; ++j) { const int c = 2 * w + j; const float m0 = sm[MST + c], m1 = sm[MST + c + 1];
        if (PASSC) sc[SMM + c * 64 + lane] = fmaxf(m0, cmj[j]);
        sc[L::SW + c * 64 + lane] = __expf(bLj[j] + pj[j] - m1); }
    f32x4 gh[2];
    const int gq = ((fq & 1) << 1) | (fq >> 1);
    if (PASSC) { gh[0] = *(const GAS f32x4*)(F.head_norm + l * D + h * 256 + 32 * w + 4 * gq); gh[1] = *(const GAS f32x4*)(F.head_norm + l * D + h * 256 + 32 * w + 16 + 4 * gq); }

    v4u graw[4];
    if (PASSC) {
#pragma unroll
        for (int tt = 0; tt < 4; ++tt) graw[tt] = *(const GAS v4u*)(MIX + (row00 + 16 * tt + fr) * 2048 + h * 256 + 32 * w + 16 * (fq >> 1) + 8 * (fq & 1));
    }
    unsigned kt0, vt0, lpS, spw, qn0, bi0, bpr, fr4, goff, dq0, dv0;
    { const unsigned l0 = (unsigned)tid0 & 63u, fr0 = l0 & 15u, fq0 = l0 >> 4, f_ = fr0 & 3u, x_ = fr0 >> 2, g1_ = fq0 >> 1, h1_ = fq0 & 1u, y_ = fr0 >> 1;
      lpS = 256u * fr0 + 64u * f_ + 16u * (fq0 ^ x_);
      bi0 = 256u * fr0 + 64u * f_ + 16u * (g1_ ^ x_) + 8u * h1_;
      spw = L_P + 128u * (16u * (unsigned)(w >> 1) + fr0) + 8u * h1_ + 16u * ((4u * (unsigned)(w & 1) + g1_) ^ y_);
      bpr = L_P + 128u * fr0 + 64u * (y_ >> 2) + 16u * (fq0 ^ (y_ & 3u));
      { const unsigned t1 = (unsigned)tid0 >> 3, part = (unsigned)tid0 & 7u; qn0 = 256u * t1 + 16u * ((2u * part) ^ swz(t1)); }
      fr4 = 4u * fr0;
      goff = 4096u * fr0 + 32u * g1_ + 16u * h1_;
      { const unsigned rr = l0 >> 4, pos = l0 & 15u;
        dq0 = (8u * (unsigned)w + rr) * 4096u + 16u * (pos ^ (rr << 2) ^ ((2u * (unsigned)w) & 3u));
        dv0 = (4u * ((4u * (unsigned)w) & 15u) + rr) * 4096u + 2048u + (unsigned)(w >> 2) * 256u + 16u * (pos ^ (rr << 2)); } }
    { const unsigned l0 = (unsigned)tid0 & 63u, g_ = l0 >> 4, q_ = (l0 & 15u) >> 2, p_ = l0 & 3u, Lx = (q_ << 1) | (g_ & 1u), pv = ((p_ & 1u) << 1) | (p_ >> 1);
      kt0 = lds_u32(lds) + L::K + 256u * (8u * g_ + q_) + 32u * Lx + 16u * (p_ >> 1) + 8u * (p_ & 1u);
      vt0 = lds_u32(lds) + L::V + (unsigned)(w >> 2) * 16384u + 256u * (8u * g_ + q_) + 32u * ((2u * (unsigned)(w & 3)) ^ Lx) + 16u * (pv >> 1) + 8u * (pv & 1u); }
    USTAMP(1);
    for (int c = 0; c < CPS; ++c) {
        asm volatile("" : "+v"(kt0), "+v"(vt0), "+v"(lpS), "+v"(spw), "+v"(qn0), "+v"(bi0), "+v"(bpr), "+v"(fr4), "+v"(goff), "+v"(dq0), "+v"(dv0));
        if (c == 8) USTAMP(2);
        { int t_ = tid0; asm volatile("" : "+v"(t_)); tid = t_; lane = t_ & 63; fr = lane & 15; fq = lane >> 4; }
        const size_t rowb = row00 + (size_t)c * CHUNK;
        const unsigned bufo = (unsigned)(PASSC ? (c & 1) : (c % 3)) * (unsigned)L::BUFB;
        const LAS unsigned char* sccb = (const LAS unsigned char*)(sc + c * 64) + fr4;
        const LAS unsigned char* smb = (const LAS unsigned char*)sm + fr4;
        LAS float* scc = sc + c * 64;
        if (PASSC) { if (c == 0) asm volatile("s_waitcnt vmcnt(0) lgkmcnt(0)" ::: "memory");
                     else asm volatile("s_waitcnt vmcnt(8) lgkmcnt(0)" ::: "memory"); }
        else if (c + 1 >= CPS) asm volatile("s_waitcnt vmcnt(0) lgkmcnt(0)" ::: "memory");
        else asm volatile("s_waitcnt vmcnt(6) lgkmcnt(0)" ::: "memory");
        __builtin_amdgcn_s_barrier();
        asm volatile("" ::: "memory");
        if (c == 8) USTAMP(4);
        if (c == 9) USTAMP(7);
        f32x4 Y[4][2];
        if (PASSC) { if (c + 1 < CPS && !(abl & 128)) dma_chunk2<PASSC>(lds, (c + 1) & 1, QKV, rowb + CHUNK, h, w, dq0, dv0); }
        else { if (c + 2 < CPS) dma_chunk2<PASSC>(lds, (c + 2) % 3, QKV, rowb + 2 * CHUNK, h, w, dq0, dv0); }
        const float mc0 = sm[MST + c];
        if (PASSC) {
            if (!(abl & 16)) { const int ti = w >> 1, sh = w & 1, t = 16 * ti + fr; const float rt = -*(const LAS float*)(sccb + 4 * (SMM + 16 * ti));
              bf16x8 ka[2][4], qb[4];
              const unsigned sqa = lpS + (bufo + (unsigned)(L::Q + 4096 * ti)), ska = lpS + (bufo + (unsigned)(L::K + 8192 * sh));
#pragma unroll
              for (int ks = 0; ks < 4; ++ks) { qb[ks] = *(const LAS bf16x8*)(lds + (sqa ^ (unsigned)(64 * ks)));
                  ka[0][ks] = *(const LAS bf16x8*)(lds + (ska ^ (unsigned)(64 * ks))); ka[1][ks] = *(const LAS bf16x8*)(lds + (ska ^ (unsigned)(64 * ks)) + 4096); }
              float rsum = 0.f;
#pragma unroll
              for (int s2 = 0; s2 < 2; ++s2) { const int si = 2 * sh + s2; f32x4 a = (f32x4){0.f, 0.f, 0.f, 0.f};
#pragma unroll
                  for (int ks = 0; ks < 4; ++ks) a = MFMA16(ka[s2][ks], qb[ks], a);
                  const f32x4 ps = *(const LAS f32x4*)(scc + SP + 16 * si + 4 * fq); f32x4 pv;
#pragma unroll
                  for (int e = 0; e < 4; ++e) { const int s = 16 * si + 4 * fq + e; pv[e] = (s <= t) ? a[e] * __expf(rt + ps[e]) : 0.f; }
                  rsum += (pv[0] + pv[1]) + (pv[2] + pv[3]);
                  v2u pk; pk.x = cvt_pk_bf16(pv[0], pv[1]); pk.y = cvt_pk_bf16(pv[2], pv[3]);
                  *(LAS v2u*)(lds + (spw ^ (unsigned)(32 * s2))) = pk; }
              rsum = xadd32(xadd16(rsum));
              if (fq == 0) *(LAS float*)((LAS unsigned char*)sm + fr4 + 4 * (RSP + sh * 64 + 16 * ti)) = rsum; }
            if (!(abl & 16)) { const int t = tid >> 3, part = tid & 7; float a = 0.f;
#pragma unroll
              for (int hh = 0; hh < 2; ++hh) { const v4u qv = *(const LAS v4u*)(lds + ((qn0 + (bufo + (unsigned)L::Q)) ^ (unsigned)(16 * hh)));
                  const f32x4 n0 = *(const LAS f32x4*)(sm + NV + 16 * part + 8 * hh), n1 = *(const LAS f32x4*)(sm + NV + 16 * part + 8 * hh + 4);
                  a += bf_lo(qv.x) * n0[0] + bf_hi(qv.x) * n0[1] + bf_lo(qv.y) * n0[2] + bf_hi(qv.y) * n0[3] + bf_lo(qv.z) * n1[0] + bf_hi(qv.z) * n1[1] + bf_lo(qv.w) * n1[2] + bf_hi(qv.w) * n1[3]; }
              a = DPP_ADD0(a, 0xB1); a = DPP_ADD0(a, 0x4E); a = DPP_ADD0(a, 0x104);
              if (part == 0) sm[QN + t] = a; }
#pragma unroll
            for (int tt = 0; tt < 4; ++tt) { Y[tt][0] = (f32x4){0.f, 0.f, 0.f, 0.f}; Y[tt][1] = Y[tt][0]; }
            if (!(abl & 64))
#pragma unroll
            for (int ks = 0; ks < 4; ++ks) { const bf16x8 cf0 = pack8(C[2 * ks][0], C[2 * ks + 1][0]), cf1 = pack8(C[2 * ks][1], C[2 * ks + 1][1]);
                bf16x8 qp[4];
                const unsigned qa0 = (bi0 + (bufo + (unsigned)L::Q)) ^ (unsigned)(64 * ks), qa1 = qa0 ^ 32u;
#pragma unroll
                for (int tt = 0; tt < 4; ++tt) {
                    const v2u q0 = *(const LAS v2u*)(lds + qa0 + 4096 * tt), q1 = *(const LAS v2u*)(lds + qa1 + 4096 * tt);
                    qp[tt] = __builtin_bit_cast(bf16x8, (v4u){q0.x, q0.y, q1.x, q1.y}); }
#pragma unroll
                for (int tt = 0; tt < 4; ++tt) { if (!(abl & 32)) { Y[tt][0] = MFMA16(cf0, qp[tt], Y[tt][0]); Y[tt][1] = MFMA16(cf1, qp[tt], Y[tt][1]); } else { Y[tt][0] += __builtin_bit_cast(f32x4, qp[tt]); } } }
        }
        const unsigned vimg = L::V + (w >> 2) * 16384, vc0 = 2 * (w & 3);
        bf16x8 VT[2][2];
        { s16x4 o[8]; const unsigned vb = vt0 + (unsigned)(PASSC ? (c & 1) : (c % 3)) * (unsigned)L::BUFB, vb16 = vb ^ 16u, vb32 = vb ^ 32u, vb48 = vb ^ 48u;
          tr_read8o<0, 1024, 8192, 9216, 0, 1024, 8192, 9216>(o, vb, vb16, vb, vb16, vb32, vb48, vb32, vb48);
#pragma unroll
          for (int vt = 0; vt < 2; ++vt)
#pragma unroll
              for (int ks = 0; ks < 2; ++ks) VT[vt][ks] = cat8(o[4 * vt + 2 * ks], o[4 * vt + 2 * ks + 1]); }
        if (PASSC) {
            LDS_WAIT(); if (!(abl & 8)) __builtin_amdgcn_s_barrier(); asm volatile("" ::: "memory");
            if (c == 8) USTAMP(5);
            bf16x8 pb[4][2];
#pragma unroll
            for (int tt = 0; tt < 4; ++tt)
#pragma unroll
                for (int ks = 0; ks < 2; ++ks) pb[tt][ks] = *(const LAS bf16x8*)(lds + (bpr ^ (unsigned)(64 * ks)) + 2048 * tt);
            float mm4[4], sb4[4], r04[4], r14[4], qn4[4];
#pragma unroll
            for (int tt = 0; tt < 4; ++tt) { mm4[tt] = *(const LAS float*)(sccb + 4 * (SMM + 16 * tt)); sb4[tt] = *(const LAS float*)(sccb + 4 * (SB + 16 * tt));
                r04[tt] = *(const LAS float*)(smb + 4 * (RSP + 16 * tt)); r14[tt] = *(const LAS float*)(smb + 4 * (RSP + 64 + 16 * tt)); qn4[tt] = *(const LAS float*)(smb + 4 * (QN + 16 * tt)); }
#pragma unroll
            for (int tt = 0; tt < 4; ++tt) { const int t = 16 * tt + fr; const float mmv = mm4[tt], iw = __expf(mc0 - mmv);
                Y[tt][0] = Y[tt][0] * iw; Y[tt][1] = Y[tt][1] * iw;
#pragma unroll
                for (int ks = 0; ks < 2; ++ks) { Y[tt][0] = MFMA16(VT[0][ks], pb[tt][ks], Y[tt][0]); Y[tt][1] = MFMA16(VT[1][ks], pb[tt][ks], Y[tt][1]); }
                const float den = r04[tt] + r14[tt] + iw * qn4[tt];
                const float hs = __builtin_amdgcn_rcpf(fmaxf(fabsf(den), __expf(-(sb4[tt] + mmv))));
                Y[tt][0] = Y[tt][0] * hs; Y[tt][1] = Y[tt][1] * hs;
                float ss = 0.f;
#pragma unroll
                for (int e = 0; e < 4; ++e) ss += Y[tt][0][e] * Y[tt][0][e] + Y[tt][1][e] * Y[tt][1][e];
                ss = xadd32(xadd16(ss));
                if (fq == 0) *(LAS float*)((LAS unsigned char*)sm + 8 * fr4 + 4 * (HN + 128 * tt + w)) = ss; }
            LDS_WAIT(); if (!(abl & 8)) __builtin_amdgcn_s_barrier(); asm volatile("" ::: "memory");
            if (c == 8) USTAMP(6);
            f32x4 hp[4][2];
#pragma unroll
            for (int tt = 0; tt < 4; ++tt) { const LAS unsigned char* hb = (const LAS unsigned char*)sm + 8 * fr4 + 4 * (HN + 128 * tt); hp[tt][0] = *(const LAS f32x4*)hb; hp[tt][1] = *(const LAS f32x4*)(hb + 16); }
#pragma unroll
            for (int tt = 0; tt < 4; ++tt) { const int t = 16 * tt + fr;
                const f32x4 hs4 = hp[tt][0] + hp[tt][1]; const float tot = (hs4[0] + hs4[1]) + (hs4[2] + hs4[3]);
                const float rn = rsqrtf(tot * (1.0f / 256.0f) + EPS);
                const auto g0 = __builtin_amdgcn_permlane32_swap(graw[tt].x, graw[tt].z, false, false), g1 = __builtin_amdgcn_permlane32_swap(graw[tt].y, graw[tt].w, false, false);
                const f32x4 y0 = Y[tt][0] * rn * gh[0], y1 = Y[tt][1] * rn * gh[1];
                const unsigned o0x = cvt_pk_bf16(y0[0] * bf_lo(g0[0]), y0[1] * bf_hi(g0[0])), o0y = cvt_pk_bf16(y0[2] * bf_lo(g1[0]), y0[3] * bf_hi(g1[0]));
                const unsigned o1x = cvt_pk_bf16(y1[0] * bf_lo(g0[1]), y1[1] * bf_hi(g0[1])), o1y = cvt_pk_bf16(y1[2] * bf_lo(g1[1]), y1[3] * bf_hi(g1[1]));
                const auto sx = __builtin_amdgcn_permlane32_swap(o0x, o1x, false, false), sy = __builtin_amdgcn_permlane32_swap(o0y, o1y, false, false);
                v4u ov; ov.x = sx[0]; ov.y = sy[0]; ov.z = sx[1]; ov.w = sy[1];
                if (!abl) *(GAS v4u*)((unsigned char*)(MIX + rowb * 2048 + h * 256 + 32 * w) + (goff + 65536u * tt)) = ov;
                else if (!(abl & 2) || (ov.x == 0x12345678u)) *(GAS v4u*)(MIXO + ((rowb + t) * 2048 + h * 256 + 32 * w + 16 * (fq >> 1) + 8 * (fq & 1)) % (size_t)(64u << 20)) = ov; }
            if (c + 1 < CPS && !(abl & 2)) {
#pragma unroll
                for (int tt = 0; tt < 4; ++tt) graw[tt] = *(const GAS v4u*)((const unsigned char*)(MIX + (rowb + CHUNK) * 2048 + h * 256 + 32 * w) + (goff + 65536u * tt));
            }
        }
        if (!(abl & 256)) { const float decay = sm[DEC + c]; float nsum = 0.f;
#pragma unroll
          for (int dt = 0; dt < 8; ++dt) { C[dt][0] = C[dt][0] * decay; C[dt][1] = C[dt][1] * decay; }
#pragma unroll
          for (int ks = 0; ks < 2; ++ks) {
              const f32x4 w0 = *(const LAS f32x4*)(scc + L::SW + 32 * ks + 8 * fq), w1 = *(const LAS f32x4*)(scc + L::SW + 32 * ks + 8 * fq + 4);
              const bf16x8 vw0 = scale8(VT[0][ks], w0, w1), vw1 = scale8(VT[1][ks], w0, w1);
              bf16x8 kt[8];
              { const unsigned kb = kt0 + (unsigned)(PASSC ? (c & 1) : (c % 3)) * (unsigned)L::BUFB;
#pragma unroll
                for (int hf = 0; hf < 2; ++hf) { s16x4 o[8];
                    const unsigned a0 = kb ^ (unsigned)(128 * hf), a1 = a0 ^ 32u, a2 = a0 ^ 64u, a3 = a0 ^ 96u;
                    if (ks == 0) tr_read8o<0, 1024, 0, 1024, 0, 1024, 0, 1024>(o, a0, a0 ^ 16u, a1, a1 ^ 16u, a2, a2 ^ 16u, a3, a3 ^ 16u);
                    else tr_read8o<8192, 9216, 8192, 9216, 8192, 9216, 8192, 9216>(o, a0, a0 ^ 16u, a1, a1 ^ 16u, a2, a2 ^ 16u, a3, a3 ^ 16u);
#pragma unroll
                    for (int j = 0; j < 4; ++j) kt[4 * hf + j] = cat8(o[2 * j], o[2 * j + 1]); } }
#pragma unroll
              for (int dt = 0; dt < 8; ++dt) { if (!(abl & 4)) { C[dt][0] = MFMA16(kt[dt], vw0, C[dt][0]); C[dt][1] = MFMA16(kt[dt], vw1, C[dt][1]); } if (dt == w) nsum += dot8(kt[dt], w0, w1); } }
          nsum = xadd32(xadd16(nsum));
          nreg = nreg * decay + nsum;
          if (PASSC && fq == 0) sm[NV + 16 * w + fr] = nreg; }
    }
    USTAMP(3);
    if (!PASSC) {
        unsigned* cp = (unsigned*)SEGC + (size_t)un * 16384 + (size_t)w * 2048 + lane * 4;
#pragma unroll
        for (int dt = 0; dt < 8; ++dt) { v4u o; o.x = cvt_pk_bf16(C[dt][0][0], C[dt][0][1]); o.y = cvt_pk_bf16(C[dt][0][2], C[dt][0][3]); o.z = cvt_pk_bf16(C[dt][1][0], C[dt][1][1]); o.w = cvt_pk_bf16(C[dt][1][2], C[dt][1][3]);
            *(GAS v4u*)(cp + dt * 256) = o; }
        if (fq == 0) SEGN[un * 128 + 16 * w + fr] = nreg;
        if (tid == 0) { SEGS[un * 4 + 0] = sum_bL; SEGS[un * 4 + 1] = m; }
    }
}
}

#ifdef DBG
constexpr int NLAYERS_RUN = 1;
#else
constexpr int NLAYERS_RUN = DEPTH;
#endif
struct Args { const float* in[10]; float* out; unsigned char* ws; };
#define REFRESH() do { int t_ = threadIdx.x; asm volatile("" : "+v"(t_)); F.tid = t_; F.lane = t_ & 63; } while (0)
__global__ void __launch_bounds__(NWAVES * 64, 2) hymba_fwd(Args args) {
    extern __shared__ __attribute__((aligned(16))) unsigned char lds_raw[];
    Frame F;
    F.lds = (LAS unsigned char*)lds_raw;
    F.tid = threadIdx.x; F.lane = F.tid & 63; F.wave = __builtin_amdgcn_readfirstlane(F.tid >> 6);
    F.G = gridDim.x; { const int bx = blockIdx.x; F.vcu = (F.G % 8 == 0) ? (bx % 8) * (F.G / 8) + bx / 8 : bx; }
    F.x = args.in[0]; F.norm_pre = args.in[1]; F.norm_post = args.in[2]; F.w_in = args.in[3]; F.b_i = args.in[4]; F.b_f = args.in[5];
    F.head_norm = args.in[6]; F.conv_w = args.in[7]; F.conv_norm = args.in[8]; F.w_out = args.in[9]; F.out = args.out; F.ws = args.ws;
    volatile LAS unsigned* MISC = (volatile LAS unsigned*)(F.lds + MISC_OFF);
    if (F.tid < 4) MISC[F.tid] = 0u;
    __syncthreads();
    XcdBarrier bar = xcd_barrier_post((unsigned*)(F.ws + WS_CTL) + CW_BAR, MISC);
#ifdef PROBE
#ifndef PROBE_BLK
#define PROBE_BLK 0
#endif
    volatile LAS unsigned long long* STAMPS = (volatile LAS unsigned long long*)(F.lds + MISC_OFF + 64);
    int n_st = 0;
#define STAMP() do { if (blockIdx.x == PROBE_BLK && threadIdx.x == 0 && n_st < 40) STAMPS[n_st] = wall_clock64(); ++n_st; } while (0)
    STAMP();
#else
#define STAMP() do {} while (0)
#endif

#ifndef NO_PREP
    REFRESH(); prep_phase(F);
    __syncthreads();
#endif
#ifndef NO_THIN
    REFRESH(); thin_phase(F, 0, true);
#endif
    xcd_barrier(bar); STAMP();
#pragma unroll 1
    for (int l = 0; l < NLAYERS_RUN; ++l) {
#ifndef NO_G1
        {
            pg8::Gemm g{(const pg8::bf16_t*)(F.ws + WS_XB), (const pg8::bf16_t*)(F.ws + WS_BT1) + (size_t)l * N1 * D, MTOK, N1, D};
            Order1 S; S.init(F.G, (int)blockIdx.x);
#ifdef G1_STAGGER
            { const unsigned long long t0 = wall_clock64(), dl = (unsigned long long)(((blockIdx.x >> 3) & 31) * G1_STAGGER);
              while (wall_clock64() - t0 < dl) __builtin_amdgcn_s_sleep(4); }
#endif
            LAS float* cwl = (LAS float*)(F.lds + CONVW_OFF);
            REFRESH();
#pragma unroll
            for (int i = 0; i < 2; ++i) { const int idx = F.tid + 512 * i;
                const float* src = idx < 768 ? F.conv_w + (size_t)l * 3 * DCONV + 4 * idx : F.conv_norm + (size_t)l * DCONV + 4 * (idx - 768);
                f32x4 v = *(const GAS f32x4*)src; if (idx >= 768) v = v * -0.6931471805599453f;
                *(LAS f32x4*)(cwl + 4 * idx) = v; }
            Epi1 E{(bf16*)(F.ws + WS_QKV), (bf16*)(F.ws + WS_MIX), (const float*)(F.ws + WS_RSTD), cwl,
                   (float*)(F.ws + WS_FIX), F.lds + EPI_OFF, (bf16*)(F.ws + WS_DBG), 0, false};
#if defined(PROBE) && defined(ABL_EPI)
            { Epi1 E2 = E; E2.mode = (ABL_EPI >= 10) ? 0 : ABL_EPI; E2.skipst = (ABL_EPI == 11) && (((const unsigned*)(F.ws + WS_CTL))[8] == 0u);
              pg8::gemm_phase<Epi1, Order1, true, true>(F.lds, g, S, E2); __syncthreads(); }
#endif
            pg8::gemm_phase<Epi1, Order1, true, true>(F.lds, g, S, E);
        }
#endif
        xcd_barrier(bar); STAMP();
#ifndef NO_MA
        REFRESH(); conv_fixup(F, l); REFRESH();
#if defined(PROBE) && defined(MA_TWICE)
        for (int un = blockIdx.x; un < NUNIT; un += F.G) ml::unit<false>(F, l, un);
#endif
#if defined(PROBE) && defined(FIX_TWICE)
        conv_fixup(F, l); conv_fixup(F, l); conv_fixup(F, l); conv_fixup(F, l);
#endif
        for (int un = blockIdx.x; un < NUNIT; un += F.G) ml::unit<false>(F, l, un);
#endif
        xcd_barrier(bar); STAMP();
#ifndef NO_MC
        REFRESH();
#if defined(PROBE) && defined(MC_DRY)
        for (int un = blockIdx.x; un < NUNIT; un += F.G) ml::unit<true>(F, l, un, MC_DRY);
#endif
        for (int un = blockIdx.x; un < NUNIT; un += F.G) ml::unit<true>(F, l, un);
#endif
        xcd_barrier(bar); STAMP();
#ifndef NO_G2
        {
            pg8::Gemm g{(const pg8::bf16_t*)(F.ws + WS_MIX), (const pg8::bf16_t*)(F.ws + WS_BT2) + (size_t)l * D * DMIX, MTOK, D, DMIX};
            pg8::StaticOrder S; S.init(MTOK, D, F.G, (int)blockIdx.x);
            Epi2 E{(bf16*)(F.ws + WS_OUT)};
#if defined(PROBE) && defined(G2_TWICE)
            pg8::gemm_phase<Epi2, pg8::StaticOrder, true, true>(F.lds, g, S, E); __syncthreads();
#endif
            pg8::gemm_phase<Epi2, pg8::StaticOrder, true, true>(F.lds, g, S, E);
        }
#endif
        xcd_barrier(bar); STAMP();
#ifndef NO_THIN
        REFRESH(); thin_phase(F, l + 1, l + 1 < NLAYERS_RUN);
#endif
        if (l + 1 < NLAYERS_RUN) xcd_barrier(bar); STAMP();
    }
#ifdef PROBE
    if (blockIdx.x == PROBE_BLK && threadIdx.x == 0) {
        asm volatile("s_waitcnt vmcnt(0)" ::: "memory");
        const unsigned long long da = STAMPS[PROBE_A1] - STAMPS[PROBE_A0];
#ifdef PROBE_FIXED
        const unsigned long long ds = PROBE_FIXED;
#else
        const unsigned long long ds = STAMPS[PROBE_S1] - STAMPS[PROBE_S0];
#endif
#ifdef PROBE_Q
        F.out[0] = (float)((da / PROBE_Q) * PROBE_Q) * 0.01f * (float)PROBE_SCALE;
#else
        F.out[0] = ((float)da * 0.01f - (float)PROBE_OFF) * (float)PROBE_SCALE;
#endif
        const unsigned long long t0 = wall_clock64(); while (wall_clock64() - t0 < (unsigned long long)PROBE_MUL * ds) __builtin_amdgcn_s_sleep(8);
    }
#endif
}

#ifdef DBG
constexpr size_t DBG_RES = 40960;
__device__ __forceinline__ float dbg_bf(bf16 v) { return __builtin_bit_cast(float, (unsigned)v << 16); }
__device__ float dbg_bsum(float v, float* sh) {
    __syncthreads(); sh[threadIdx.x] = v; __syncthreads();
    for (int o = 128; o > 0; o >>= 1) { if ((int)threadIdx.x < o) sh[threadIdx.x] += sh[threadIdx.x + o]; __syncthreads(); }
    const float r = sh[0]; __syncthreads(); return r;
}
__device__ float dbg_rstd(const float* xrow, float* sh) { float s = 0.f; for (int k = threadIdx.x; k < D; k += 256) s += xrow[k] * xrow[k]; return rsqrtf(dbg_bsum(s, sh) * (1.0f / D) + EPS); }
__device__ float dbg_dot(const float* xrow, const float* gp, const float* W, int col, float* sh) {
    float s = 0.f; for (int k = threadIdx.x; k < D; k += 256) s += xrow[k] * gp[k] * W[(size_t)k * INCOLS + col]; return dbg_bsum(s, sh);
}
__device__ void dbg_acc(float* res, int bit, float e2, float r2) { if (threadIdx.x == 0) { atomicAdd(res + bit, e2); atomicAdd(res + 16 + bit, r2); } }
constexpr int DBG_N1 = 48, DBG_N2 = 24, DBG_NG = 16, DBG_N3 = 12, DBG_N4 = 8, DBG_N5 = 32;
__global__ void __launch_bounds__(256) dbg_check(Args a) {
    __shared__ float sh[256]; __shared__ float vals[3][4][64]; __shared__ float Fc[4096]; __shared__ float scs[4096]; __shared__ float tot[256];
    const float* x = a.in[0]; const float* gp = a.in[1]; const float* W = a.in[3]; const float* cw = a.in[7]; const float* cg = a.in[8];
    float* res = (float*)(a.ws + WS_CTL + DBG_RES);
    const bf16* QKV = (const bf16*)(a.ws + WS_QKV); const bf16* MIX = (const bf16*)(a.ws + WS_MIX); const bf16* DBGG = (const bf16*)(a.ws + WS_DBG);
    const float* LI = (const float*)(a.ws + WS_LI); const float* LF = (const float*)(a.ws + WS_LF);
    int id = blockIdx.x; const int tid = threadIdx.x;
    if (id < DBG_N1) {
        const int i = id, r = (int)(((unsigned)i * 7919u + 13u) & 65535u), pn = i & 7, ci = (i * 37 + 5) & 255, cc = 256 * pn + ci;
        const float rs = dbg_rstd(x + (size_t)r * D, sh);
        const float ref = dbg_dot(x + (size_t)r * D, gp, W, cc, sh) * rs * (cc < 512 ? 0.08838834764831845f : 1.0f);
        const float val = dbg_bf(QKV[(size_t)r * 2048 + cc]);
        dbg_acc(res, 0, (val - ref) * (val - ref), ref * ref); return;
    }
    id -= DBG_N1;
    if (id < DBG_N2) {
        const int i = id, r = (int)(((unsigned)i * 104729u + 77u) & 65535u), ch = (i * 131 + 9) & 1023;
        const float rs = dbg_rstd(x + (size_t)r * D, sh);
        const float o = dbg_dot(x + (size_t)r * D, gp, W, 2048 + ch, sh) * rs, z = dbg_dot(x + (size_t)r * D, gp, W, 3072 + ch, sh) * rs;
        const float ref = z / (1.f + expf(-z)) / (1.f + expf(-o));
        const float val = dbg_bf(DBGG[(size_t)r * 1024 + ch]);
        dbg_acc(res, 0, (val - ref) * (val - ref), ref * ref); return;
    }
    id -= DBG_N2;
    if (id < DBG_NG) {
        const int i = id, r = (int)(((unsigned)i * 31337u + 5u) & 65535u), h = i & 3, b = r >> 12, t = r & 4095;
        const float rs = dbg_rstd(x + (size_t)r * D, sh);
        const float ip = dbg_dot(x + (size_t)r * D, gp, W, 4096 + h, sh) * rs + a.in[4][h], fp = dbg_dot(x + (size_t)r * D, gp, W, 4100 + h, sh) * rs + a.in[5][h];
        const float lfr = fminf(fp, 0.f) - log1pf(expf(-fabsf(fp)));
        const float v1 = LI[(size_t)(b * 4 + h) * SEQ + t], v2 = LF[(size_t)(b * 4 + h) * SEQ + t];
        dbg_acc(res, 0, (v1 - ip) * (v1 - ip) + (v2 - lfr) * (v2 - lfr), ip * ip + lfr * lfr); return;
    }
    id -= DBG_NG;
    if (id < 5 * DBG_N3) {
        const int cat = id / DBG_N3, i = id % DBG_N3, g = (i * 5 + cat) & 15;
        int rb = (int)(((unsigned)(i + 1) * 2654435761u >> 8) & 65535u) & ~255, off;
        if (cat == 0) off = 5 + (i % 10);
        else if (cat == 1) off = 16 * (1 + i % 3) + (i & 1);
        else if (cat == 2) off = 64 * (1 + i % 3) + (i & 1);
        else if (cat == 3) { off = (i & 1); if (((rb >> 8) & 15) == 0) rb += 256; }
        else { rb &= ~4095; off = (i & 1); }
        const int r = rb + off, t = r & (SEQ - 1), qn = tid >> 6, c = tid & 63, col = 4104 + 1024 * qn + 64 * g + c;
        for (int j = 0; j < 3; ++j) {
            const int tj = t - 2 + j; float v = 0.f;
            if (tj >= 0) { const float* xr = x + (size_t)(r - 2 + j) * D; const float rs = dbg_rstd(xr, sh);
                float s = 0.f; for (int k = 0; k < D; ++k) s += xr[k] * gp[k] * W[(size_t)k * INCOLS + col]; v = s * rs; }
            vals[j][qn][c] = v;
        }
        __syncthreads();
        float y = 0.f, bc = 0.f;
        if (qn == 0) { const int ch = 64 * g + c;
            const float cu0 = vals[0][0][c] * vals[0][2][c], cu1 = vals[1][0][c] * vals[1][2][c], cu2 = vals[2][0][c] * vals[2][2][c];
            bc = vals[2][1][c] * (cw[ch] * cu0 + cw[1024 + ch] * cu1 + cw[2048 + ch] * cu2); }
        const float ss = dbg_bsum(qn == 0 ? bc * bc : 0.f, sh);
        float e2 = 0.f, r2 = 0.f;
        if (qn == 0) { const int ch = 64 * g + c; const float z = vals[2][3][c]; y = z / (1.f + expf(-z)) * bc * rsqrtf(ss * (1.0f / 64.0f) + EPS) * cg[ch];
            const float val = dbg_bf(MIX[(size_t)r * 2048 + 1024 + ch]); e2 = (val - y) * (val - y); r2 = y * y; }
        e2 = dbg_bsum(e2, sh); r2 = dbg_bsum(r2, sh);
        dbg_acc(res, cat < 3 ? 1 : 2, e2, r2); return;
    }
    id -= 5 * DBG_N3;
    if (id < 3 * DBG_N4) {
        const int cat = id / DBG_N4, i = id % DBG_N4, bh = (i * 13 + cat * 7) & 63, b = bh >> 2, h = bh & 3;
        int t;
        if (cat == 0) { const int tt[8] = {0, 1, 5, 17, 31, 37, 62, 63}; t = tt[i]; }
        else if (cat == 1) { const int tt[8] = {64, 65, 100, 127, 128, 500, 1000, 1023}; t = tt[i]; }
        else { const int tt[8] = {1024, 1025, 1500, 2047, 2048, 3000, 3071, 4095}; t = tt[i]; }
        const size_t rbase = (size_t)b * SEQ, r = rbase + t;
        { float run = 0.f; for (int j = 0; j < 16; ++j) { run += LF[(size_t)bh * SEQ + tid * 16 + j]; Fc[tid * 16 + j] = run; } tot[tid] = run; }
        __syncthreads();
        if (tid == 0) { float run = 0.f; for (int j = 0; j < 256; ++j) { const float v = tot[j]; tot[j] = run; run += v; } }
        __syncthreads();
        for (int j = 0; j < 16; ++j) Fc[tid * 16 + j] += tot[tid];
        __syncthreads();
        const float Ft = Fc[t];
        float dsum = 0.f;
        for (int s = tid; s <= t; s += 256) { float d = 0.f;
            for (int k = 0; k < 128; ++k) d += dbg_bf(QKV[r * 2048 + h * 128 + k]) * dbg_bf(QKV[(rbase + s) * 2048 + 512 + h * 128 + k]);
            const float w = expf(Ft - Fc[s] + LI[(size_t)bh * SEQ + s]) * d; scs[s] = w; dsum += w; }
        const float den = dbg_bsum(dsum, sh);
        float num = 0.f;
        for (int s = 0; s <= t; ++s) num += scs[s] * dbg_bf(QKV[(rbase + s) * 2048 + 1024 + h * 256 + tid]);
        const float hv = num / fmaxf(fabsf(den), 1.0f);
        const float ssq = dbg_bsum(hv * hv, sh);
        const float ref = dbg_bf(DBGG[r * 1024 + h * 256 + tid]) * hv * rsqrtf(ssq * (1.0f / 256.0f) + EPS) * a.in[6][h * 256 + tid];
        const float val = dbg_bf(MIX[r * 2048 + h * 256 + tid]);
        const float e2 = dbg_bsum((val - ref) * (val - ref), sh), r2 = dbg_bsum(ref * ref, sh);
        dbg_acc(res, 3 + cat, e2, r2); return;
    }
    id -= 3 * DBG_N4;
    if (id < DBG_N5) {
        const int i = id, r = (int)(((unsigned)i * 48271u + 11u) & 65535u), c = (i * 173 + 3) & 1023;
        const bf16* OUTB = (const bf16*)(a.ws + WS_OUT);
        float s = 0.f; for (int k = tid; k < DMIX; k += 256) s += dbg_bf(MIX[(size_t)r * 2048 + k]) * a.in[9][(size_t)k * D + c];
        const float ref = dbg_bsum(s, sh), val = dbg_bf(OUTB[(size_t)r * D + c]);
        float q = 0.f; for (int k = tid; k < D; k += 256) { const float o = dbg_bf(OUTB[(size_t)r * D + k]); q += o * o; }
        const float rs = rsqrtf(dbg_bsum(q, sh) * (1.0f / D) + EPS);
        const float ref2 = x[(size_t)r * D + c] + val * rs * a.in[2][c], val2 = a.out[(size_t)r * D + c];
        dbg_acc(res, 6, (val - ref) * (val - ref) + (val2 - ref2) * (val2 - ref2), ref * ref + ref2 * ref2); return;
    }
}
__global__ void __launch_bounds__(256) dbg_report(Args a) {
    const float* res = (const float*)(a.ws + WS_CTL + DBG_RES);
    int mask = 0;
    for (int i = 0; i < 7; ++i) { const float e = res[i], r = res[16 + i]; if (!(e <= 0.0025f * r) || !(r > 0.f)) mask |= 1 << i; }
    const size_t n = (size_t)MTOK * D;
    for (size_t i = (size_t)blockIdx.x * 256 + threadIdx.x; i < n; i += (size_t)gridDim.x * 256) a.out[i] = 0.f;
    if (blockIdx.x == 0 && threadIdx.x == 0) a.out[0] = ldexpf(1.0f, (mask < 120 ? mask : 120) + 4);
}
#endif
extern "C" void kernel_launch(void* const* d_in, const int* in_sizes, int n_in, void* d_out, int out_size, void* d_ws, size_t ws_size, hipStream_t stream) {
    static int grid = 0;
    if (grid == 0) {
        if (n_in != 10 || out_size != MTOK * D || ws_size < WS_END) { fprintf(stderr, "kernel_launch: unexpected shapes (n_in %d, out %d, ws %zu)\n", n_in, out_size, ws_size); grid = -1; return; }
        int dev = 0, cus = 0, per_cu = 0;
        if (hipGetDevice(&dev) != hipSuccess || hipDeviceGetAttribute(&cus, hipDeviceAttributeMultiprocessorCount, dev) != hipSuccess) { grid = -1; return; }
        if (hipFuncSetAttribute((const void*)hymba_fwd, hipFuncAttributeMaxDynamicSharedMemorySize, LDS_BYTES) != hipSuccess) { fprintf(stderr, "kernel_launch: hipFuncSetAttribute failed\n"); grid = -1; return; }
        if (hipOccupancyMaxActiveBlocksPerMultiprocessor(&per_cu, (const void*)hymba_fwd, NWAVES * 64, LDS_BYTES) != hipSuccess || per_cu < 1) { fprintf(stderr, "kernel_launch: occupancy query says %d\n", per_cu); grid = -1; return; }
        if (cus < 256) { fprintf(stderr, "kernel_launch: built for 256 CUs, device reports %d\n", cus); grid = -1; return; }
        grid = 256;
    }
    if (grid <= 0) return;
    if (hipMemsetAsync((char*)d_ws + WS_CTL, 0, CTL_ZERO_BYTES, stream) != hipSuccess) return;
    Args a{};
    for (int i = 0; i < 10; ++i) a.in[i] = (const float*)d_in[i];
    a.out = (float*)d_out; a.ws = (unsigned char*)d_ws;
    hipLaunchKernelGGL(hymba_fwd, dim3(grid), dim3(NWAVES * 64), LDS_BYTES, stream, a);
#ifdef DBG
    hipLaunchKernelGGL(dbg_check, dim3(DBG_N1 + DBG_N2 + DBG_NG + 5 * DBG_N3 + 3 * DBG_N4 + DBG_N5), dim3(256), 0, stream, a);
    hipLaunchKernelGGL(dbg_report, dim3(1024), dim3(256), 0, stream, a);
#endif
}
```

```cpp
#include <hip/hip_runtime.h>
#include <cstdio>
#include <cstdint>
namespace pg8 {
#define PG8_LAS __attribute__((address_space(3)))
typedef unsigned short bf16_t;
typedef short bf16x8 __attribute__((ext_vector_type(8)));
typedef float f32x4 __attribute__((ext_vector_type(4)));
typedef unsigned u32x4 __attribute__((ext_vector_type(4)));
constexpr int BM = 256, BK = 64, HALF = 128, HTB = HALF * BK * 2  , STAGE_BYTES = 8 * HTB, NXCD = 8, WGM = 8;

__host__ __device__ __forceinline__ int lds_byte(int r, int c) { const int st = (r >> 4) * 2 + (c >> 5), rr = r & 15, cc = c & 31, ob = rr * 64 + cc * 2; return st * 1024 + (ob ^ (((ob >> 9) & 1) << 5)); }
__host__ __device__ __forceinline__ void stage_rc(int b, int& R, int& C) { const int st = b / 1024, sb = b % 1024, swz = sb ^ (((sb >> 9) & 1) << 5); R = (st >> 1) * 16 + swz / 64; C = (st & 1) * 32 + (swz % 64) / 2; }
__host__ __device__ __forceinline__ int perm32(int rho) { const int n = rho >> 4, i = rho & 15; return 8 * (i >> 2) + 4 * n + (i & 3); }

struct Unit { int pm, pn; };
struct Gemm { const bf16_t* A; const bf16_t* Bt; int M, N, K; };

struct StaticOrder {
    int nM, nN, nwg, G, c;
    __host__ __device__ void init(int M, int N, int G_, int c_) { nM = M / BM; nN = N / BM; nwg = nM * nN; G = G_; c = c_; }
    __host__ __device__ bool next(int i, Unit& u) const {
        const long L = (long)i * G + c; if (L >= nwg) return false;
        int wgid = (int)L; { const int q = nwg / NXCD, r = nwg % NXCD, xcd = wgid % NXCD, off = wgid / NXCD; wgid = (xcd < r ? xcd * (q + 1) : r * (q + 1) + (xcd - r) * q) + off; }
        const int nig = WGM * nN, gid = wgid / nig, fm = gid * WGM, gsz = (nM - fm) < WGM ? (nM - fm) : WGM;
        u.pm = fm + ((wgid % nig) % gsz); u.pn = (wgid % nig) / gsz; return true;
    }
    __device__ __forceinline__ void a_ready(const Unit&) const {}
    __device__ __forceinline__ void done(const Unit&) const {}
};

__device__ __forceinline__ unsigned cvt_pk_bf16(float lo, float hi) { unsigned r; asm volatile("v_cvt_pk_bf16_f32 %0, %1, %2" : "=v"(r) : "v"(lo), "v"(hi)); return r; }
typedef float f32x2 __attribute__((ext_vector_type(2)));
template <class Epi, class Sched, bool ALIGN_EPI = false, bool SP2 = false>
__device__ __forceinline__ void gemm_phase(PG8_LAS unsigned char* lds, const Gemm g, const Sched& S, const Epi& E) {
    int tid_ = threadIdx.x; asm volatile("" : "+v"(tid_));
    const int tid = tid_, wid = __builtin_amdgcn_readfirstlane(tid >> 6), lane = tid & 63, wr = wid >> 2, wc = wid & 3, fr = lane & 15, fq = lane >> 4;
    const int K = g.K, nt = K / BK;
    unsigned voffA[2], voffB[2];
#pragma unroll
    for (int i = 0; i < 2; ++i) { int R, C; stage_rc(tid * 16 + i * 8192, R, C); const int Rb = Epi::PERM ? ((R & ~31) + perm32(R & 31)) : R;
        voffA[i] = (unsigned)(R * K + C) * 2u; voffB[i] = (unsigned)(Rb * K + C) * 2u; }
    const size_t kstep = (size_t)(BK * 2);
    const size_t hstep = (size_t)HALF * K * 2;
    const size_t tstep = 2 * hstep;
    const unsigned ldsw = (unsigned)wid * 1024u;
    const int aoff = lds_byte(wr * 64 + fr, fq * 8), boff = lds_byte(wc * 32 + fr, fq * 8);
#define PG8_SA(b, h) (((b) * 2 + (h)) * HTB)
#define PG8_SB(b, h) ((4 + (b) * 2 + (h)) * HTB)
#define PG8_STAGE(bufoff, gbase, voff) do { _Pragma("unroll") for (int _i = 0; _i < 2; ++_i) \
        __builtin_amdgcn_global_load_lds((const unsigned*)((const char*)(gbase) + (voff)[_i]), (PG8_LAS unsigned*)(lds + (bufoff) + ldsw + _i * 8192), 16, 0, 0); } while (0)
#define PG8_LDA(dst, b, h) do { _Pragma("unroll") for (int m = 0; m < 4; ++m) _Pragma("unroll") for (int k = 0; k < 2; ++k) dst[m][k] = *(const PG8_LAS bf16x8*)(lds + PG8_SA(b, h) + aoff + m * 2048 + k * 1024); } while (0)
#define PG8_LDB(dst, b, h) do { _Pragma("unroll") for (int n = 0; n < 2; ++n) _Pragma("unroll") for (int k = 0; k < 2; ++k) dst[n][k] = *(const PG8_LAS bf16x8*)(lds + PG8_SB(b, h) + boff + n * 2048 + k * 1024); } while (0)
#define PG8_MMA(ai, bj, At, Bt) do { __builtin_amdgcn_s_setprio(1); _Pragma("unroll") for (int m = 0; m < 4; ++m) _Pragma("unroll") for (int n = 0; n < 2; ++n) _Pragma("unroll") for (int k = 0; k < 2; ++k) \
        acc[ai][bj][m][n] = __builtin_amdgcn_mfma_f32_16x16x32_bf16(Bt[n][k], At[m][k], acc[ai][bj][m][n], 0, 0, 0); __builtin_amdgcn_s_setprio(0); } while (0)
#define PG8_WAIT_V(n) asm volatile("s_waitcnt vmcnt(" #n ")" ::: "memory")
#define PG8_WAIT_L(n) asm volatile("s_waitcnt lgkmcnt(" #n ")" ::: "memory")
#define PG8_BAR __builtin_amdgcn_s_barrier()
#define PG8_SCHED __builtin_amdgcn_sched_barrier(0)
    Unit cur, nxt; int ui = 0;
    if (!S.next(0, cur)) return;
    f32x4 acc[2][2][4][2];
#pragma unroll
    for (int a = 0; a < 2; ++a)
#pragma unroll
        for (int b = 0; b < 2; ++b)
#pragma unroll
            for (int m = 0; m < 4; ++m)
#pragma unroll
                for (int n = 0; n < 2; ++n) acc[a][b][m][n] = (f32x4){0.f, 0.f, 0.f, 0.f};
    bf16x8 At[4][2], B0[2][2], B1[2][2];
    const char* cA = (const char*)g.A + (size_t)cur.pm * tstep; const char* cB = (const char*)g.Bt + (size_t)cur.pn * tstep;
    S.a_ready(cur);
    if constexpr (SP2) {
        PG8_STAGE(PG8_SB(0, 0), cB, voffB); PG8_STAGE(PG8_SB(0, 1), cB + hstep, voffB); PG8_STAGE(PG8_SA(0, 0), cA, voffA); PG8_STAGE(PG8_SA(0, 1), cA + hstep, voffA);
        if (wr == 1) PG8_BAR;
        PG8_WAIT_V(2); PG8_BAR;
        PG8_STAGE(PG8_SB(1, 0), cB + kstep, voffB); PG8_STAGE(PG8_SA(1, 0), cA + kstep, voffA); PG8_STAGE(PG8_SB(1, 1), cB + hstep + kstep, voffB);
        PG8_WAIT_V(6); PG8_BAR;
    } else {
        PG8_STAGE(PG8_SB(0, 0), cB, voffB); PG8_STAGE(PG8_SA(0, 0), cA, voffA); PG8_STAGE(PG8_SB(0, 1), cB + hstep, voffB); PG8_STAGE(PG8_SA(0, 1), cA + hstep, voffA);
        if (wr == 1) PG8_BAR;
        PG8_WAIT_V(4); PG8_BAR;
        PG8_STAGE(PG8_SB(1, 0), cB + kstep, voffB); PG8_STAGE(PG8_SA(1, 0), cA + kstep, voffA); PG8_STAGE(PG8_SB(1, 1), cB + hstep + kstep, voffB);
        PG8_WAIT_V(6); PG8_BAR;
    }
    for (;;) {
        const bool has_next = S.next(ui + 1, nxt);
        const char* nA = has_next ? (const char*)g.A + (size_t)nxt.pm * tstep : cA; const char* nB = has_next ? (const char*)g.Bt + (size_t)nxt.pn * tstep : cB;
        for (int t = 0; t < nt; t += 2) {
            const bool last = (t == nt - 2);
            const char* a1 = cA + (size_t)(t + 1) * kstep;
            const char* a2 = last ? nA : cA + (size_t)(t + 2) * kstep; const char* b2 = last ? nB : cB + (size_t)(t + 2) * kstep;
            const char* a3 = a2 + kstep; const char* b3 = b2 + kstep;
            if (last && has_next) S.a_ready(nxt);
            if constexpr (SP2) {
            PG8_LDB(B0, 0, 0); PG8_LDB(B1, 0, 1); PG8_SCHED; PG8_LDA(At, 0, 0); PG8_STAGE(PG8_SA(1, 1), a1 + hstep, voffA);
            PG8_WAIT_V(8); PG8_WAIT_L(0); PG8_BAR; PG8_MMA(0, 0, At, B0); PG8_MMA(0, 1, At, B1); PG8_BAR; PG8_SCHED;
            PG8_LDA(At, 0, 1); PG8_STAGE(PG8_SB(0, 0), b2, voffB); PG8_STAGE(PG8_SB(0, 1), b2 + hstep, voffB); PG8_STAGE(PG8_SA(0, 0), a2, voffA);
            PG8_WAIT_V(8); PG8_WAIT_L(0); PG8_BAR; PG8_MMA(1, 0, At, B0); PG8_MMA(1, 1, At, B1); PG8_BAR; PG8_SCHED;
            PG8_LDB(B0, 1, 0); PG8_LDB(B1, 1, 1); PG8_SCHED; PG8_LDA(At, 1, 0); PG8_STAGE(PG8_SA(0, 1), a2 + hstep, voffA);
            PG8_WAIT_V(8); PG8_WAIT_L(0); PG8_BAR; PG8_MMA(0, 0, At, B0); PG8_MMA(0, 1, At, B1); PG8_BAR; PG8_SCHED;
            PG8_LDA(At, 1, 1); PG8_STAGE(PG8_SB(1, 0), b3, voffB); PG8_STAGE(PG8_SB(1, 1), b3 + hstep, voffB); PG8_STAGE(PG8_SA(1, 0), a3, voffA);
            PG8_WAIT_V(8); PG8_WAIT_L(0); PG8_BAR; PG8_MMA(1, 0, At, B0); PG8_MMA(1, 1, At, B1); PG8_BAR; PG8_SCHED;
            } else {
            PG8_LDB(B0, 0, 0); PG8_SCHED; PG8_LDA(At, 0, 0); PG8_STAGE(PG8_SA(1, 1), a1 + hstep, voffA);
            PG8_WAIT_L(8); PG8_BAR; PG8_WAIT_L(0); PG8_MMA(0, 0, At, B0); PG8_BAR; PG8_SCHED;
            PG8_LDB(B1, 0, 1); PG8_STAGE(PG8_SB(0, 0), b2, voffB);
            PG8_BAR; PG8_WAIT_L(0); PG8_MMA(0, 1, At, B1); PG8_BAR;
            PG8_LDA(At, 0, 1); PG8_STAGE(PG8_SA(0, 0), a2, voffA);
            PG8_BAR; PG8_WAIT_L(0); PG8_MMA(1, 0, At, B0); PG8_BAR; PG8_SCHED;
            PG8_STAGE(PG8_SB(0, 1), b2 + hstep, voffB);
            PG8_WAIT_V(6); PG8_BAR; PG8_MMA(1, 1, At, B1); PG8_BAR;
            PG8_LDB(B0, 1, 0); PG8_SCHED; PG8_LDA(At, 1, 0); PG8_STAGE(PG8_SA(0, 1), a2 + hstep, voffA);
            PG8_WAIT_L(8); PG8_BAR; PG8_WAIT_L(0); PG8_MMA(0, 0, At, B0); PG8_BAR; PG8_SCHED;
            PG8_LDB(B1, 1, 1); PG8_STAGE(PG8_SB(1, 0), b3, voffB);
            PG8_BAR; PG8_WAIT_L(0); PG8_MMA(0, 1, At, B1); PG8_BAR;
            PG8_LDA(At, 1, 1); PG8_STAGE(PG8_SA(1, 0), a3, voffA);
            PG8_BAR; PG8_WAIT_L(0); PG8_MMA(1, 0, At, B0); PG8_BAR; PG8_SCHED;
            PG8_STAGE(PG8_SB(1, 1), b3 + hstep, voffB);
            PG8_WAIT_V(6); PG8_BAR; PG8_MMA(1, 1, At, B1); PG8_BAR;
            }
        }
        if constexpr (ALIGN_EPI) { if (wr == 0) PG8_BAR; }
        if constexpr (!Epi::AFTER_DRAIN) { E(acc, cur, wr, wc, fr, fq); S.done(cur); }
        if (!has_next) break;
#pragma unroll
        for (int a = 0; a < 2; ++a)
#pragma unroll
            for (int b = 0; b < 2; ++b)
#pragma unroll
                for (int m = 0; m < 4; ++m)
#pragma unroll
                    for (int n = 0; n < 2; ++n) acc[a][b][m][n] = (f32x4){0.f, 0.f, 0.f, 0.f};
        cur = nxt; cA = nA; cB = nB; ++ui;
        if constexpr (ALIGN_EPI) { if (wr == 1) PG8_BAR; }
    }
    PG8_WAIT_V(0);
    if constexpr (!ALIGN_EPI) { if (wr == 0) PG8_BAR; }
    PG8_BAR;
    if constexpr (Epi::AFTER_DRAIN) { E.fused(acc, cur, wr, wc, fr, fq, lds, wid, lane); S.done(cur); }
#undef PG8_SA
#undef PG8_SB
#undef PG8_STAGE
#undef PG8_LDA
#undef PG8_LDB
#undef PG8_MMA
#undef PG8_WAIT_V
#undef PG8_WAIT_L
#undef PG8_BAR
#undef PG8_SCHED
}
}

constexpr int D = 1024, BATCH = 16, SEQ = 4096, DEPTH = 4, MTOK = BATCH * SEQ;
constexpr int NH = 4, DV = 256, DQK = 128, INCOLS = 8200, N1 = 8192, DMIX = 2048, DCONV = 1024;
constexpr int CHUNK = 64, NCH = SEQ / CHUNK, NSEG = 4, CPS = NCH / NSEG;
constexpr int NUNIT = BATCH * NH * NSEG;
constexpr float EPS = 1e-6f;
constexpr int NWAVES = 8;

constexpr size_t MiB = 1u << 20;
constexpr size_t WS_CTL = 0, CTL_ZERO_BYTES = 65536;
constexpr size_t WS_BT1 = 2 * MiB;
constexpr size_t WS_BT2 = 66 * MiB;
constexpr size_t WS_WG = 82 * MiB;
constexpr size_t WS_RSTD = 83 * MiB;
constexpr size_t WS_LI = 84 * MiB;
constexpr size_t WS_LF = 85 * MiB;
constexpr size_t WS_FIX = 86 * MiB;
constexpr size_t FIX_ARR = 256 * 2 * 1024;
constexpr size_t WS_SEGC = 94 * MiB;
constexpr size_t WS_SEGN = 126 * MiB;
constexpr size_t WS_SEGS = 127 * MiB;
constexpr size_t WS_XB = 128 * MiB;
constexpr size_t WS_QKV = 256 * MiB;
constexpr size_t WS_MIX = 512 * MiB;
constexpr size_t WS_OUT = 768 * MiB;
constexpr size_t WS_END = 896 * MiB;
constexpr size_t WS_DBG = 896 * MiB;
constexpr int CW_BAR = 4096;

constexpr int RING_BYTES = 131072;
constexpr int EPI_OFF = RING_BYTES;
constexpr int CONVW_OFF = EPI_OFF + 8192;
constexpr int LDS_BYTES = 163840;
constexpr int MISC_OFF = LDS_BYTES - 512;

#define GAS __attribute__((address_space(1)))
#define LAS __attribute__((address_space(3)))
typedef unsigned short bf16;
typedef unsigned v4u __attribute__((ext_vector_type(4)));
typedef unsigned v2u __attribute__((ext_vector_type(2)));
typedef float f32x4 __attribute__((ext_vector_type(4)));
typedef short bf16x8 __attribute__((ext_vector_type(8)));
typedef short s16x4 __attribute__((ext_vector_type(4)));
#define LDS_WAIT() asm volatile("s_waitcnt lgkmcnt(0)" ::: "memory")
#define VM_WAIT() asm volatile("s_waitcnt vmcnt(0)" ::: "memory")
using pg8::cvt_pk_bf16;
__device__ __forceinline__ float bf_lo(unsigned u) { return __builtin_bit_cast(float, u << 16); }
__device__ __forceinline__ float bf_hi(unsigned u) { return __builtin_bit_cast(float, u & 0xffff0000u); }
__device__ __forceinline__ float dpp_ror1(float v) { return __int_as_float(__builtin_amdgcn_mov_dpp(__float_as_int(v), 0x121, 0xf, 0xf, true)); }
__device__ __forceinline__ float dpp_ror2(float v) { return __int_as_float(__builtin_amdgcn_mov_dpp(__float_as_int(v), 0x122, 0xf, 0xf, true)); }
__device__ __forceinline__ float dpp_shr1(float old, float v) { return __int_as_float(__builtin_amdgcn_update_dpp(__float_as_int(old), __float_as_int(v), 0x111, 0xf, 0xf, false)); }
__device__ __forceinline__ float dpp_shr2(float old, float v) { return __int_as_float(__builtin_amdgcn_update_dpp(__float_as_int(old), __float_as_int(v), 0x112, 0xf, 0xf, false)); }
__device__ __forceinline__ float sigmoidf_(float x) { return 1.0f / (1.0f + __expf(-x)); }
__device__ __forceinline__ float xadd16(float v) { const auto r = __builtin_amdgcn_permlane16_swap(__float_as_uint(v), __float_as_uint(v), false, false); return __uint_as_float(r[0]) + __uint_as_float(r[1]); }
__device__ __forceinline__ float xadd32(float v) { const auto r = __builtin_amdgcn_permlane32_swap(__float_as_uint(v), __float_as_uint(v), false, false); return __uint_as_float(r[0]) + __uint_as_float(r[1]); }
#define DPP_ADD0(v, ctrl) ((v) + __int_as_float(__builtin_amdgcn_update_dpp(0, __float_as_int(v), (ctrl), 0xf, 0xf, false)))
__device__ __forceinline__ float wave_sum(float v) {
    v = DPP_ADD0(v, 0xB1); v = DPP_ADD0(v, 0x4E); v = DPP_ADD0(v, 0x124); v = DPP_ADD0(v, 0x128);
    return xadd32(xadd16(v));
}

#define XB_TMO      128
#define XB_XCNT(j)  (256  + 64 * (j))
#define XB_XSUB(j)  (1280 + 64 * (j))
#define XB_XGEN(j)  (2304 + 64 * (j))
#define XB_TOP      3328
#define XB_TOPGEN   3392
#define XCD_BAR_WORDS 3456
#define XB_SPIN_CAP (1u << 18)
__device__ __forceinline__ unsigned xb_ld(unsigned* p)              { return __hip_atomic_load(p, __ATOMIC_RELAXED, __HIP_MEMORY_SCOPE_AGENT); }
__device__ __forceinline__ unsigned xb_add(unsigned* p, unsigned v) { return __hip_atomic_fetch_add(p, v, __ATOMIC_RELAXED, __HIP_MEMORY_SCOPE_AGENT); }
__device__ __forceinline__ unsigned xb_xcc_id() { return (unsigned)__builtin_amdgcn_s_getreg((3 << 11) | 20) & 0xFu; }
#define XB_SPIN(cond, bar) do { unsigned _sp = 0; while (cond) { __builtin_amdgcn_s_sleep(1); \
    if ((++_sp & 255u) == 0u) { if (xb_ld(&(bar)[XB_TMO])) break; if (_sp > XB_SPIN_CAP) { atomicAdd(&(bar)[XB_TMO], 1u); break; } } } } while (0)
struct XcdBarrier { unsigned* bar; unsigned x; volatile LAS unsigned* st; };
__device__ __forceinline__ XcdBarrier xcd_barrier_post(unsigned* bar, volatile LAS unsigned* st) {
    XcdBarrier b; b.bar = bar; b.x = xb_xcc_id(); b.st = st;
    if (threadIdx.x == 0) (void)xb_add(&bar[XB_XCNT(b.x)], 1u);
    return b;
}
__device__ __forceinline__ void xcd_barrier_complete(unsigned* bar, unsigned x, unsigned& nloc, unsigned& nx) {
    const unsigned G = gridDim.x * gridDim.y * gridDim.z;
    unsigned sum, cnt, mine, sp = 0u;
    for (;;) {
        sum = 0u; cnt = 0u; mine = 0u;
#pragma unroll
        for (unsigned j = 0; j < 16; ++j) { const unsigned c = xb_ld(&bar[XB_XCNT(j)]); sum += c; cnt += (c > 0u) ? 1u : 0u; mine = (j == x) ? c : mine; }
        if (sum == G) break;
        __builtin_amdgcn_s_sleep(1);
        if ((++sp & 255u) == 0u) { if (xb_ld(&bar[XB_TMO])) break; if (sp > XB_SPIN_CAP) { atomicAdd(&bar[XB_TMO], 1u); break; } }
    }
    nloc = mine > 0u ? mine : 1u; nx = cnt > 0u ? cnt : 1u;
}
__device__ __forceinline__ void xcd_barrier(const XcdBarrier& b) {
    asm volatile("s_waitcnt vmcnt(0)" ::: "memory");
    __syncthreads();
    if (threadIdx.x == 0) {
        unsigned* bar = b.bar; const unsigned bx = xb_xcc_id();
        __builtin_amdgcn_s_waitcnt(0);
        unsigned nloc = b.st[0], nx = b.st[1];
        if (nloc == 0u) { xcd_barrier_complete(bar, bx, nloc, nx); b.st[0] = nloc; b.st[1] = nx; }
        const unsigned old = xb_add(&bar[XB_XSUB(bx)], 1u);
        const unsigned gen = old / nloc;
        if (old + 1u == (gen + 1u) * nloc) {
            __builtin_amdgcn_fence(__ATOMIC_RELEASE, "agent");
            asm volatile("s_waitcnt vmcnt(0)" ::: "memory");
            const unsigned og = xb_add(&bar[XB_TOP], 1u);
            const unsigned tg = og / nx;
            if (og + 1u == (tg + 1u) * nx) xb_add(&bar[XB_TOPGEN], 1u);
            else XB_SPIN(xb_ld(&bar[XB_TOPGEN]) == tg, bar);
            __builtin_amdgcn_fence(__ATOMIC_ACQUIRE, "agent");
            xb_add(&bar[XB_XGEN(bx)], 1u);
            asm volatile("s_waitcnt vmcnt(0)" ::: "memory");
        } else {
            XB_SPIN(xb_ld(&bar[XB_XGEN(bx)]) == gen, bar);
            __builtin_amdgcn_fence(__ATOMIC_ACQUIRE, "agent");
            asm volatile("s_waitcnt vmcnt(0)" ::: "memory");
        }
    }
    __syncthreads();
}

struct Frame {
    LAS unsigned char* lds;
    int tid, lane, wave, vcu, G;
    const float *x, *norm_pre, *norm_post, *w_in, *b_i, *b_f, *head_norm, *conv_w, *conv_norm, *w_out;
    float* out;
    unsigned char* ws;
};

__host__ __device__ __forceinline__ int rho_plain(int ci) {
    const int wc = ci >> 6, bj = (ci >> 5) & 1, fq = (ci >> 3) & 3, n = (ci >> 2) & 1, e = ci & 3;
    return 128 * bj + 32 * wc + 16 * n + 4 * fq + e;
}
__host__ __device__ __forceinline__ int dest1(int cc) {
    if (cc < 2048) return (cc & ~255) + rho_plain(cc & 255);
    if (cc < 4096) { const int qn = (cc - 2048) >> 10, ch = cc & 1023, gt = ch >> 7, c = ch & 127;
        const int wc = c >> 5, fq = (c >> 3) & 3, bj = (c >> 2) & 1, e = c & 3;
        return 256 * (8 + gt) + 128 * bj + 32 * wc + 16 * qn + 4 * fq + e; }
    { const int qn = (cc - 4096) >> 10, ch = cc & 1023, g = ch >> 6, c = ch & 63;
      const int wc = c >> 4, fq = ((c >> 3) & 1) | (((c >> 2) & 1) << 1), e = c & 3, bj = qn >> 1, n = qn & 1;
      return 256 * (16 + g) + 128 * bj + 32 * wc + 16 * n + 4 * fq + e; }
}

struct PrepItem { const float* W; const float* gk; bf16* WT; int ldw, k0, src, cc0, Kd, which; float cscale; };
__device__ __forceinline__ PrepItem prep_item(const Frame& F, int it) {
    constexpr int I1 = 16 * 256, I2 = 32 * 32;
    const int l = it / (I1 + I2); int r = it % (I1 + I2); PrepItem p;
    if (r < I1) { const int kb = r >> 8, cb = r & 255, cc0 = cb * 32;
        p.W = F.w_in + (size_t)l * D * INCOLS; p.ldw = INCOLS; p.k0 = kb * 64; p.src = cc0 < 4096 ? cc0 : cc0 + 8; p.cc0 = cc0; p.gk = F.norm_pre + l * D; p.cscale = cc0 < 512 ? 0.08838834764831845f : ((cc0 >= 2048 && cc0 < 4096) || cc0 >= 7168) ? -1.4426950408889634f : 1.0f;
        p.WT = (bf16*)(F.ws + WS_BT1) + (size_t)l * N1 * D; p.Kd = D; p.which = 0;
    } else { r -= I1; const int kb = r >> 5, cb = r & 31;
        p.W = F.w_out + (size_t)l * DMIX * D; p.ldw = D; p.k0 = kb * 64; p.src = cb * 32; p.cc0 = cb * 32; p.gk = F.norm_pre; p.cscale = 1.0f;
        p.WT = (bf16*)(F.ws + WS_BT2) + (size_t)l * D * DMIX; p.Kd = DMIX; p.which = 1; }
    return p;
}
__device__ __forceinline__ void prep_load(const PrepItem& p, f32x4 (&ld)[8], int lane) {
#pragma unroll
    for (int i = 0; i < 8; ++i) ld[i] = *(const GAS f32x4*)(p.W + (size_t)(p.k0 + 8 * i + (lane >> 3)) * p.ldw + p.src + 4 * (lane & 7));
}
__device__ __forceinline__ void prep_finish(const PrepItem& p, const f32x4 (&ld)[8], LAS float* scr, int lane) {
#pragma unroll
    for (int i = 0; i < 8; ++i) { const int kk = 8 * i + (lane >> 3); f32x4 v = ld[i];
        if (p.which == 0) v = v * (p.gk[p.k0 + kk] * p.cscale);
        LAS float* d = scr + kk * 33 + 4 * (lane & 7); d[0] = v.x; d[1] = v.y; d[2] = v.z; d[3] = v.w; }
    LDS_WAIT(); asm volatile("" ::: "memory");
    const int c = lane & 7;
#pragma unroll
    for (int j = 0; j < 4; ++j) { const int n = (lane >> 3) + 8 * j; const LAS float* s = scr + (8 * c) * 33 + n;
        v4u o; o.x = cvt_pk_bf16(s[0 * 33], s[1 * 33]); o.y = cvt_pk_bf16(s[2 * 33], s[3 * 33]); o.z = cvt_pk_bf16(s[4 * 33], s[5 * 33]); o.w = cvt_pk_bf16(s[6 * 33], s[7 * 33]);
        const int cc = p.cc0 + n; const int row = (p.which == 0) ? dest1(cc) : ((cc & ~255) + rho_plain(cc & 255));
        *(GAS v4u*)(p.WT + (size_t)row * p.Kd + p.k0 + 8 * c) = o; }
    LDS_WAIT(); asm volatile("" ::: "memory");
}
__device__ __forceinline__ void prep_phase(Frame& F) {
    LAS float* scr = (LAS float*)(F.lds + F.wave * 16384);
    const int gw = F.vcu * NWAVES + F.wave, NGW = F.G * NWAVES;
    constexpr int NIT = DEPTH * (16 * 256 + 32 * 32);
    f32x4 la[8], lb[8]; PrepItem pa, pb;
    int it = gw;
    if (it < NIT) { pa = prep_item(F, it); prep_load(pa, la, F.lane); }
    for (; it < NIT; it += 2 * NGW) {
        const bool hb = it + NGW < NIT;
        if (hb) { pb = prep_item(F, it + NGW); prep_load(pb, lb, F.lane); }
        prep_finish(pa, la, scr, F.lane);
        if (hb) {
            if (it + 2 * NGW < NIT) { pa = prep_item(F, it + 2 * NGW); prep_load(pa, la, F.lane); }
            prep_finish(pb, lb, scr, F.lane);
        }
    }
    float* wg = (float*)(F.ws + WS_WG);
    for (int i = (F.vcu * NWAVES + F.wave) * 64 + F.lane; i < DEPTH * 8 * D; i += F.G * NWAVES * 64) {
        const int l = i / (8 * D), j = (i / D) & 7, k = i % D;
        wg[i] = F.w_in[(size_t)l * D * INCOLS + (size_t)k * INCOLS + 4096 + j] * F.norm_pre[l * D + k];
    }
}

#define DPP_ADD(v, ctrl) ((v) + __int_as_float(__builtin_amdgcn_update_dpp(0, __float_as_int(v), (ctrl), 0xf, 0xf, false)))
__device__ __forceinline__ float row_sum16(float v) { v = DPP_ADD(v, 0xB1); v = DPP_ADD(v, 0x4E); v = DPP_ADD(v, 0x124); v = DPP_ADD(v, 0x128); return v; }
__device__ __forceinline__ float wave_sum2(float v) { v = row_sum16(v); v = xadd32(xadd16(v)); return v; }
typedef __bf16 bf16x2_t __attribute__((ext_vector_type(2)));
__device__ __forceinline__ float dot2bf(unsigned a, unsigned b, float acc) { return __builtin_amdgcn_fdot2_f32_bf16(__builtin_bit_cast(bf16x2_t, a), __builtin_bit_cast(bf16x2_t, b), acc, false); }
__device__ __forceinline__ float dpp_x1(float v) { return __int_as_float(__builtin_amdgcn_update_dpp(0, __float_as_int(v), 0xB1, 0xf, 0xf, false)); }
__device__ __forceinline__ float dpp_x2(float v) { return __int_as_float(__builtin_amdgcn_update_dpp(0, __float_as_int(v), 0x4E, 0xf, 0xf, false)); }
constexpr int TNR = 2;
struct ThinCtx { const float* x; bf16* XB; const bf16* OUTB; float* out; float* RSTD; float* LI; float* LF; LAS float* wgl; int l, lane; bool wn; float bi, bfv; };
__device__ __forceinline__ void thin_load(const ThinCtx& c, v4u (&raw)[TNR][4], float (&rsd)[TNR], const size_t m0, const size_t mstep) {
#pragma unroll
    for (int r = 0; r < TNR; ++r) { const size_t m = m0 + (size_t)r * mstep;
        rsd[r] = 1.0f;
        if (c.l == 0) {
#pragma unroll
            for (int q = 0; q < 4; ++q) raw[r][q] = *(const GAS v4u*)(c.x + m * D + 256 * q + 4 * c.lane);
        } else {
            rsd[r] = c.RSTD[m];
#pragma unroll
            for (int q = 0; q < 4; ++q) { const v2u a = *(const GAS v2u*)(c.XB + m * D + 256 * q + 4 * c.lane), b = *(const GAS v2u*)(c.OUTB + m * D + 256 * q + 4 * c.lane);
                raw[r][q] = (v4u){a.x, a.y, b.x, b.y}; }
        } }
}
__device__ __forceinline__ void thin_rows(const ThinCtx& c, const v4u (&raw)[TNR][4], const float (&rsd)[TNR], const f32x4 (&gp)[4], const size_t m0, const size_t mstep) {
    const int lane = c.lane;
#pragma unroll
    for (int r = 0; r < TNR; ++r) { const size_t m = m0 + (size_t)r * mstep;
        f32x4 v[4];
        if (c.l == 0) {
#pragma unroll
            for (int q = 0; q < 4; ++q) v[q] = __builtin_bit_cast(f32x4, raw[r][q]);
        } else {
            f32x4 o[4]; float ss = 0.f;
            const float unr = 1.0f / rsd[r];
#pragma unroll
            for (int q = 0; q < 4; ++q) { const v4u w = raw[r][q]; v[q] = (f32x4){bf_lo(w.x), bf_hi(w.x), bf_lo(w.y), bf_hi(w.y)} * unr;
                o[q] = (f32x4){bf_lo(w.z), bf_hi(w.z), bf_lo(w.w), bf_hi(w.w)}; ss += (o[q].x * o[q].x + o[q].y * o[q].y) + (o[q].z * o[q].z + o[q].w * o[q].w); }
            const float rs = rsqrtf(wave_sum2(ss) * (1.0f / D) + EPS);
#pragma unroll
            for (int q = 0; q < 4; ++q) { v[q] = v[q] + o[q] * rs * gp[q]; if (!c.wn) *(GAS f32x4*)(c.out + m * D + 256 * q + 4 * lane) = v[q]; }
        }
        if (c.wn) {
            float ss = 0.f;
#pragma unroll
            for (int q = 0; q < 4; ++q) ss += (v[q].x * v[q].x + v[q].y * v[q].y) + (v[q].z * v[q].z + v[q].w * v[q].w);
            ss = row_sum16(ss); ss = xadd32(xadd16(ss));
            const float rstd = rsqrtf(ss * (1.0f / D) + EPS);
            unsigned xw[8];
#pragma unroll
            for (int q = 0; q < 4; ++q) { const f32x4 vn = v[q] * rstd; xw[2 * q] = cvt_pk_bf16(vn.x, vn.y); xw[2 * q + 1] = cvt_pk_bf16(vn.z, vn.w);
                *(GAS v2u*)(c.XB + m * D + 256 * q + 4 * lane) = (v2u){xw[2 * q], xw[2 * q + 1]}; }
            if (lane == 0) c.RSTD[m] = rstd;
            float a[8];
#pragma unroll
            for (int j = 0; j < 8; ++j) { const v4u w0 = *(const LAS v4u*)((LAS unsigned*)c.wgl + (j * 64 + lane) * 8), w1 = *(const LAS v4u*)((LAS unsigned*)c.wgl + (j * 64 + lane) * 8 + 4);
                float s = 0.f;
                s = dot2bf(xw[0], w0.x, s); s = dot2bf(xw[1], w0.y, s); s = dot2bf(xw[2], w0.z, s); s = dot2bf(xw[3], w0.w, s);
                s = dot2bf(xw[4], w1.x, s); s = dot2bf(xw[5], w1.y, s); s = dot2bf(xw[6], w1.z, s); s = dot2bf(xw[7], w1.w, s);
                a[j] = s; }
            const bool o1 = lane & 1, o2 = lane & 2;
            float b4[4];
#pragma unroll
            for (int i = 0; i < 4; ++i) { const float keep = o1 ? a[2 * i + 1] : a[2 * i], send = o1 ? a[2 * i] : a[2 * i + 1]; b4[i] = keep + dpp_x1(send); }
            float c2[2];
#pragma unroll
            for (int i = 0; i < 2; ++i) { const float keep = o2 ? b4[2 * i + 1] : b4[2 * i], send = o2 ? b4[2 * i] : b4[2 * i + 1]; c2[i] = keep + dpp_x2(send); }
#pragma unroll
            for (int i = 0; i < 2; ++i) { c2[i] = DPP_ADD(c2[i], 0x124); c2[i] = DPP_ADD(c2[i], 0x128); c2[i] = xadd32(xadd16(c2[i])); }
            if (lane < 4) { const int b = (int)(m >> 12), t = (int)(m & (SEQ - 1));
                const float xi = c2[0] + c.bi, xf = c2[1] + c.bfv;
                c.LI[(size_t)(b * NH + lane) * SEQ + t] = xi;
                c.LF[(size_t)(b * NH + lane) * SEQ + t] = fminf(xf, 0.f) - __logf(1.0f + __expf(-fabsf(xf))); }
        }
    }
}
__device__ __forceinline__ void thin_phase(Frame& F, const int l, const bool wn) {
    const int gw = F.vcu * NWAVES + F.wave, NGW = F.G * NWAVES, lane = F.lane;
    ThinCtx c; c.x = F.x; c.XB = (bf16*)(F.ws + WS_XB); c.OUTB = (const bf16*)(F.ws + WS_OUT); c.out = F.out; c.RSTD = (float*)(F.ws + WS_RSTD);
    c.LI = (float*)(F.ws + WS_LI); c.LF = (float*)(F.ws + WS_LF); c.wgl = (LAS float*)F.lds; c.l = l; c.lane = lane; c.wn = wn; c.bi = 0.f; c.bfv = 0.f;
    if (wn) {
        const float* wgp = (const float*)(F.ws + WS_WG) + (size_t)l * 8 * D;
#pragma unroll
        for (int i = 0; i < 4; ++i) { const int idx = F.tid + 512 * i, j = idx >> 8, k4 = idx & 255, q = k4 >> 6, ln = k4 & 63;
            f32x4 wv;
            if (l == 0) { const float* wc0 = F.w_in + (size_t)(4 * k4) * INCOLS + 4096 + j; const f32x4 gpre = *(const GAS f32x4*)(F.norm_pre + 4 * k4);
                wv = (f32x4){wc0[0] * gpre.x, wc0[INCOLS] * gpre.y, wc0[2 * INCOLS] * gpre.z, wc0[3 * INCOLS] * gpre.w}; }
            else wv = *(const GAS f32x4*)(wgp + j * D + 4 * k4);
            v2u pk; pk.x = cvt_pk_bf16(wv.x, wv.y); pk.y = cvt_pk_bf16(wv.z, wv.w);
            *(LAS v2u*)((LAS unsigned*)c.wgl + (j * 64 + ln) * 8 + 2 * q) = pk; }
        c.bi = F.b_i[l * NH + (lane & 3)]; c.bfv = F.b_f[l * NH + (lane & 3)];
    }
    __syncthreads();
    f32x4 gp[4];
#pragma unroll
    for (int q = 0; q < 4; ++q) gp[q] = (f32x4){0.f, 0.f, 0.f, 0.f};
    if (l > 0) {
#pragma unroll
        for (int q = 0; q < 4; ++q) gp[q] = *(const GAS f32x4*)(F.norm_post + (l - 1) * D + 256 * q + 4 * lane);
    }
    const size_t step = (size_t)NGW, trip = TNR * (size_t)NGW;
    v4u ra[TNR][4], rb[TNR][4]; float sa[TNR], sb[TNR];
    size_t m0 = (size_t)gw;
    thin_load(c, ra, sa, m0, step);
    for (; m0 < (size_t)MTOK; m0 += 2 * trip) {
        if (m0 + trip < (size_t)MTOK) thin_load(c, rb, sb, m0 + trip, step);
        thin_rows(c, ra, sa, gp, m0, step);
        if (m0 + trip < (size_t)MTOK) {
            if (m0 + 2 * trip < (size_t)MTOK) thin_load(c, ra, sa, m0 + 2 * trip, step);
            thin_rows(c, rb, sb, gp, m0 + trip, step);
        }
    }
    __syncthreads();
}

__device__ __forceinline__ unsigned dppx1u(unsigned v) { return (unsigned)__builtin_amdgcn_update_dpp(0, (int)v, 0xB1, 0xf, 0xf, false); }
template <bool SKIPPABLE>
__device__ __forceinline__ void store_plain_tile(const pg8::f32x4 (&acc)[2][2][4][2], bf16* base, size_t ld, int row0, int col0, int fr, int fq, bool skip) {
    const bool odd = fr & 1;
#pragma unroll
    for (int ai = 0; ai < 2; ++ai)
#pragma unroll
        for (int m = 0; m < 4; ++m) {
            v4u a[2];
#pragma unroll
            for (int bj = 0; bj < 2; ++bj) { const f32x4 v0 = acc[ai][bj][m][0], v1 = acc[ai][bj][m][1];
                a[bj].x = cvt_pk_bf16(v0[0], v0[1]); a[bj].y = cvt_pk_bf16(v0[2], v0[3]); a[bj].z = cvt_pk_bf16(v1[0], v1[1]); a[bj].w = cvt_pk_bf16(v1[2], v1[3]); }
            const v4u snd = odd ? a[0] : a[1];
            v4u rcv; rcv.x = dppx1u(snd.x); rcv.y = dppx1u(snd.y); rcv.z = dppx1u(snd.z); rcv.w = dppx1u(snd.w);
            const int r = row0 + ai * 128 + m * 16;
            bf16* pe = base + (size_t)(r & ~1) * ld + col0 + (odd ? 32 : 0) + 8 * fq;
            bf16* po = base + (size_t)(r | 1) * ld + col0 + (odd ? 32 : 0) + 8 * fq;
            const v4u de = odd ? rcv : a[0], dq = odd ? a[1] : rcv;
            if (!SKIPPABLE || !skip) { *(GAS v4u*)pe = de; *(GAS v4u*)po = dq; }
        }
}
#ifdef PROBE
#define EPI_ST(stmt) { if (!skipst) { stmt } }
#else
#define EPI_ST(stmt) { stmt }
#endif
#ifdef USE_NT
#define NT_ST(p, v) __builtin_nontemporal_store((v), (p))
#else
#define NT_ST(p, v) (*(p) = (v))
#endif
struct Epi1 {
    static constexpr bool PERM = false, AFTER_DRAIN = false;
    bf16* QKV; bf16* MIX; const float* RSTD; const LAS float* cwl; float* fix; LAS unsigned char* elds; bf16* DBGG; int mode; bool skipst;
    __device__ __forceinline__ void operator()(pg8::f32x4 (&acc)[2][2][4][2], const pg8::Unit& u, int wr, int wc, int fr, int fq) const {
        asm volatile("" : "+v"(fr), "+v"(fq));
        const int row0 = u.pm * 256 + wr * 64 + fr;
#ifdef PROBE
        if (mode == 3) {
            f32x4 s = (f32x4){0.f, 0.f, 0.f, 0.f};
#pragma unroll
            for (int ai = 0; ai < 2; ++ai)
#pragma unroll
                for (int bj = 0; bj < 2; ++bj)
#pragma unroll
                    for (int mm = 0; mm < 4; ++mm) s += acc[ai][bj][mm][0] + acc[ai][bj][mm][1];
            EPI_ST(*(GAS f32x4*)(fix + 4 * FIX_ARR + (size_t)(wr * 4 + wc) * 256 + (fq * 16 + fr) * 4) = s;)
            return; }
        if (mode == 2 || u.pn < 8) {
#else
        if (u.pn < 8) {
#endif
#ifdef PROBE
            store_plain_tile<true>(acc, QKV, 2048, row0, (u.pn & 7) * 256 + 64 * wc, fr, fq, skipst);
#else
            store_plain_tile<false>(acc, QKV, 2048, row0, (u.pn & 7) * 256 + 64 * wc, fr, fq, false);
#endif
        } else if (u.pn < 16) {
#pragma unroll
            for (int ai = 0; ai < 2; ++ai)
#pragma unroll
                for (int m = 0; m < 4; ++m) { const int r = row0 + ai * 128 + m * 16;
                    f32x4 g[2];
#pragma unroll
                    for (int bj = 0; bj < 2; ++bj) { const f32x4 os = acc[ai][bj][m][0], zs = acc[ai][bj][m][1]; f32x4 a, b, r;
#pragma unroll
                        for (int e = 0; e < 4; ++e) { a[e] = __builtin_amdgcn_exp2f(zs[e]); b[e] = __builtin_amdgcn_exp2f(os[e]); }
                        const f32x4 d = (a * -1.4426950408889634f + -1.4426950408889634f) * (b + 1.0f);
#pragma unroll
                        for (int e = 0; e < 4; ++e) r[e] = __builtin_amdgcn_rcpf(d[e]);
                        g[bj] = zs * r; }
                    v4u w; w.x = cvt_pk_bf16(g[0][0], g[0][1]); w.y = cvt_pk_bf16(g[0][2], g[0][3]); w.z = cvt_pk_bf16(g[1][0], g[1][1]); w.w = cvt_pk_bf16(g[1][2], g[1][3]);
                    EPI_ST(NT_ST((v4u*)(MIX + (size_t)r * 2048 + (u.pn - 8) * 128 + 32 * wc + 8 * fq), w);)
#ifdef DBG
                    EPI_ST(*(GAS v4u*)(DBGG + (size_t)r * 1024 + (u.pn - 8) * 128 + 32 * wc + 8 * fq) = w;)
#endif
                    }
        } else {
            const int g = u.pn - 16, ch0 = 64 * g + 16 * wc + 8 * (fq & 1) + 4 * (fq >> 1);
            LAS float* halo = (LAS float*)elds;
            LAS float* part = (LAS float*)(elds + 2048);
            float* cuL = fix; float* cuF = fix + FIX_ARR; float* bF = fix + 2 * FIX_ARR; float* zF = fix + 3 * FIX_ARR;
#pragma unroll
            for (int ai = 0; ai < 2; ++ai)
#pragma unroll
                for (int m = 0; m < 4; ++m) acc[ai][0][m][0] = acc[ai][0][m][0] * acc[ai][1][m][0];
#pragma unroll
            for (int ai = 0; ai < 2; ++ai) {
                if (fr >= 14) { *(LAS f32x4*)(halo + ((2 * ai + wr) * 2 + (fr - 14)) * 64 + 16 * wc + 4 * fq) = acc[ai][0][3][0];
                    if (ai == 1 && wr == 1) EPI_ST(*(GAS f32x4*)(cuL + ((size_t)u.pm * 2 + (fr - 14)) * 1024 + ch0) = acc[1][0][3][0];) }
            }
            if (wr == 0 && fr < 2) { const size_t o = ((size_t)u.pm * 2 + fr) * 1024 + ch0;
                EPI_ST(*(GAS f32x4*)(cuF + o) = acc[0][0][0][0];) EPI_ST(*(GAS f32x4*)(bF + o) = acc[0][0][0][1];) EPI_ST(*(GAS f32x4*)(zF + o) = acc[0][1][0][1];) }
            LDS_WAIT(); __builtin_amdgcn_s_barrier(); asm volatile("" ::: "memory");
            const f32x4 w0 = *(const LAS f32x4*)(cwl + ch0), w1 = *(const LAS f32x4*)(cwl + 1024 + ch0), w2 = *(const LAS f32x4*)(cwl + 2048 + ch0);
#pragma unroll
            for (int ai = 0; ai < 2; ++ai) {
                const int blk = 2 * ai + wr;
                f32x4 p1 = (f32x4){0.f, 0.f, 0.f, 0.f}, p2 = p1;
                if (blk > 0) { p1 = *(const LAS f32x4*)(halo + ((blk - 1) * 2 + 1) * 64 + 16 * wc + 4 * fq); p2 = *(const LAS f32x4*)(halo + ((blk - 1) * 2 + (fr & 1)) * 64 + 16 * wc + 4 * fq); }
#pragma unroll
                for (int m = 0; m < 4; ++m) {
                    const f32x4 cu = acc[ai][0][m][0]; f32x4 s1, s2, a1, a2;
#pragma unroll
                    for (int e = 0; e < 4; ++e) { a1[e] = dpp_shr1(p1[e], cu[e]); a2[e] = dpp_shr2(p2[e], cu[e]);
                        if (m < 3) { s1[e] = dpp_ror1(cu[e]); s2[e] = dpp_ror2(cu[e]); } else { s1[e] = 0.f; s2[e] = 0.f; } }
                    const f32x4 cv = w2 * cu + w1 * a1 + w0 * a2;
                    const f32x4 bc = acc[ai][0][m][1] * cv;
                    acc[ai][1][m][0] = bc;
                    float ss = (bc[0] * bc[0] + bc[1] * bc[1]) + (bc[2] * bc[2] + bc[3] * bc[3]);
                    ss = xadd32(xadd16(ss));
                    if (fq == 0) part[(128 * ai + 64 * wr + 16 * m + fr) * 4 + wc] = ss;
                    p1 = s1; p2 = s2;
                }
            }
            LDS_WAIT(); __builtin_amdgcn_s_barrier(); asm volatile("" ::: "memory");
            const f32x4 gc = *(const LAS f32x4*)(cwl + 3072 + ch0);
#pragma unroll
            for (int ai = 0; ai < 2; ++ai)
#pragma unroll
                for (int mp = 0; mp < 2; ++mp) {
                    v2u wq[2];
#pragma unroll
                    for (int mo = 0; mo < 2; ++mo) { const int m = 2 * mp + mo, rt = 128 * ai + 64 * wr + 16 * m + fr;
                        const f32x4 ps = *(const LAS f32x4*)(part + rt * 4);
                        const float rg = __builtin_amdgcn_rsqf(((ps[0] + ps[1]) + (ps[2] + ps[3])) * (1.0f / 64.0f) + EPS);
                        const f32x4 zs = acc[ai][1][m][1], bc = acc[ai][1][m][0]; f32x4 a, r;
#pragma unroll
                        for (int e = 0; e < 4; ++e) a[e] = __builtin_amdgcn_exp2f(zs[e]);
                        a = a + 1.0f;
#pragma unroll
                        for (int e = 0; e < 4; ++e) r[e] = __builtin_amdgcn_rcpf(a[e]);
                        const f32x4 y = (zs * r) * (bc * (gc * rg));
                        wq[mo].x = cvt_pk_bf16(y[0], y[1]); wq[mo].y = cvt_pk_bf16(y[2], y[3]); }
                    const auto sx = __builtin_amdgcn_permlane32_swap(wq[0].x, wq[1].x, false, false), sy = __builtin_amdgcn_permlane32_swap(wq[0].y, wq[1].y, false, false);
                    v4u w; w.x = sx[0]; w.y = sy[0]; w.z = sx[1]; w.w = sy[1];
                    const int rt = 128 * ai + 64 * wr + 16 * (2 * mp + (fq >> 1)) + fr;
                    EPI_ST(*(GAS v4u*)(MIX + (size_t)(u.pm * 256 + rt) * 2048 + 1024 + 64 * g + 16 * wc + 8 * (fq & 1)) = w;) }
        }
    }
};
struct Order1 {
    pg8::StaticOrder sc, sg, sq, sall; int rc, rg; bool sweeps;
    __device__ void init(int G_, int c_) { sc.init(MTOK, 4096, G_, c_); sg.init(MTOK, 2048, G_, c_); sq.init(MTOK, 2048, G_, c_); sall.init(MTOK, N1, G_, c_);
        rc = sc.nwg / G_; rg = sg.nwg / G_; sweeps = (sc.nwg % G_ == 0) && (sg.nwg % G_ == 0); }
    __device__ bool next(int i, pg8::Unit& u) const {
        if (!sweeps) return sall.next(i, u);
        if (i < rc) { sc.next(i, u); u.pn += 16; return true; }
#ifdef ORDER_QKV_BEFORE_GATE
        if (i < rc + rg) { sq.next(i - rc, u); return true; }
        if (i < rc + 2 * rg) { sg.next(i - rc - rg, u); u.pn += 8; return true; }
#else
        if (i < rc + rg) { sg.next(i - rc, u); u.pn += 8; return true; }
        if (i < rc + 2 * rg) { sq.next(i - rc - rg, u); return true; }
#endif
        return false;
    }
    __device__ __forceinline__ void a_ready(const pg8::Unit&) const {}
    __device__ __forceinline__ void done(const pg8::Unit&) const {}
};
struct Epi2 {
    static constexpr bool PERM = false, AFTER_DRAIN = false;
    bf16* O;
    __device__ __forceinline__ void operator()(pg8::f32x4 (&acc)[2][2][4][2], const pg8::Unit& u, int wr, int wc, int fr, int fq) const {
        const int row0 = u.pm * 256 + wr * 64 + fr;
        store_plain_tile<false>(acc, O, 1024, row0, u.pn * 256 + 64 * wc, fr, fq, false);
    }
};

__device__ __forceinline__ void conv_fixup(Frame& F, const int l) {
    const float* fix = (const float*)(F.ws + WS_FIX);
    const float *cuL = fix, *cuF = fix + FIX_ARR, *bF = fix + 2 * FIX_ARR, *zF = fix + 3 * FIX_ARR;
    const float* cw = F.conv_w + (size_t)l * 3 * DCONV; const float* cg = F.conv_norm + (size_t)l * DCONV;
    bf16* MIX = (bf16*)(F.ws + WS_MIX);
    const int gw = F.vcu * NWAVES + F.wave, NGW = F.G * NWAVES, lane = F.lane;
    for (int it0 = gw; it0 < 256 * 2 * 16; it0 += 4 * NGW) {
        float c0[4], c1[4], pl0[4], pl1[4], bb[4], zz[4], w0[4], w1[4], w2[4], gg[4];
#pragma unroll
        for (int k = 0; k < 4; ++k) { const int it = it0 + k * NGW, pm = (it >> 5) & 255, rr = (it >> 4) & 1, g = it & 15, ch = 64 * g + lane, pmp = pm > 0 ? pm - 1 : 0;
            c0[k] = cuF[((size_t)pm * 2 + 0) * 1024 + ch]; c1[k] = cuF[((size_t)pm * 2 + 1) * 1024 + ch];
            pl0[k] = cuL[((size_t)pmp * 2 + 0) * 1024 + ch]; pl1[k] = cuL[((size_t)pmp * 2 + 1) * 1024 + ch];
            bb[k] = bF[((size_t)pm * 2 + rr) * 1024 + ch]; zz[k] = zF[((size_t)pm * 2 + rr) * 1024 + ch];
            w0[k] = cw[ch]; w1[k] = cw[1024 + ch]; w2[k] = cw[2048 + ch]; gg[k] = cg[ch]; }
#pragma unroll
        for (int k = 0; k < 4; ++k) { const int it = it0 + k * NGW, pm = it >> 5, rr = (it >> 4) & 1, g = it & 15, ch = 64 * g + lane;
            if (it >= 256 * 2 * 16 || (pm & 15) == 0) continue;
            const float cv = rr == 0 ? (w2[k] * c0[k] + w1[k] * pl1[k] + w0[k] * pl0[k]) : (w2[k] * c1[k] + w1[k] * c0[k] + w0[k] * pl1[k]);
            const float bc = bb[k] * cv;
            const float rg = rsqrtf(wave_sum(bc * bc) * (1.0f / 64.0f) + EPS);
            const float z = zz[k] * -0.6931471805599453f;
            const float y = z * sigmoidf_(z) * bc * rg * gg[k];
            MIX[(size_t)(pm * 256 + rr) * 2048 + 1024 + ch] = (bf16)(cvt_pk_bf16(y, y) & 0xffffu); }
    }
}

namespace ml {
#ifndef MC_ABL
#define MC_ABL 0
#endif
template <bool PASSC> struct Lay;
template <> struct Lay<true>  { static constexpr int NBUF = 2, BUFB = 65536, Q = 0, K = 16384, V = 32768, SC = 139264, SW = 3072, SM = 4096; };
template <> struct Lay<false> { static constexpr int NBUF = 3, BUFB = 49152, Q = 0, K = 0, V = 16384, SC = 147456, SW = 0, SM = 1024; };
constexpr int L_P = 131072;
constexpr int SP = 0, SMM = 1024, SB = 2048;
constexpr int RSP = 0, QN = 128, HN = 192, NV = 704, DEC = 832, MST = 848, BLS = 868, CML = 884;
static_assert(Lay<true>::SC + (Lay<true>::SM + 900) * 4 <= MISC_OFF && Lay<false>::SC + (Lay<false>::SM + 900) * 4 <= MISC_OFF && Lay<false>::NBUF * Lay<false>::BUFB <= Lay<false>::SC, "mLSTM LDS map");
__device__ __forceinline__ unsigned swz(unsigned row) { return ((row & 3) << 2) | ((row >> 2) & 3); }
__device__ __forceinline__ unsigned off_b(unsigned row, unsigned ch) { return 256u * row + 16u * (ch ^ swz(row)); }
__device__ __forceinline__ unsigned tr_addr16(unsigned lane, unsigned c, unsigned ks, unsigned t) {
    const unsigned g = lane >> 4, q = (lane & 15) >> 2, p = lane & 3;
    return off_b(32 * ks + 8 * g + 4 * t + q, 2 * c + (p >> 1)) + 8 * (p & 1);
}
__device__ __forceinline__ unsigned tr_addr16v(unsigned lane, unsigned c, unsigned ks, unsigned t) {
    const unsigned g = lane >> 4, q = (lane & 15) >> 2, p0 = lane & 3, p = ((p0 & 1) << 1) | (p0 >> 1);
    return off_b(32 * ks + 8 * g + 4 * t + q, 2 * c + (p >> 1)) + 8 * (p & 1);
}
__device__ __forceinline__ void tr_read8(s16x4 (&o)[8], const unsigned (&a)[8]) {
    asm volatile("ds_read_b64_tr_b16 %0, %8\n\tds_read_b64_tr_b16 %1, %9\n\tds_read_b64_tr_b16 %2, %10\n\tds_read_b64_tr_b16 %3, %11\n\t"
                 "ds_read_b64_tr_b16 %4, %12\n\tds_read_b64_tr_b16 %5, %13\n\tds_read_b64_tr_b16 %6, %14\n\tds_read_b64_tr_b16 %7, %15\n\ts_waitcnt lgkmcnt(0)"
                 : "=&v"(o[0]), "=&v"(o[1]), "=&v"(o[2]), "=&v"(o[3]), "=&v"(o[4]), "=&v"(o[5]), "=&v"(o[6]), "=&v"(o[7])
                 : "v"(a[0]), "v"(a[1]), "v"(a[2]), "v"(a[3]), "v"(a[4]), "v"(a[5]), "v"(a[6]), "v"(a[7]) : "memory");
}
template <int O0, int O1, int O2, int O3, int O4, int O5, int O6, int O7>
__device__ __forceinline__ void tr_read8o(s16x4 (&o)[8], unsigned a0, unsigned a1, unsigned a2, unsigned a3, unsigned a4, unsigned a5, unsigned a6, unsigned a7) {
    asm volatile("ds_read_b64_tr_b16 %0, %8 offset:%16\n\tds_read_b64_tr_b16 %1, %9 offset:%17\n\tds_read_b64_tr_b16 %2, %10 offset:%18\n\tds_read_b64_tr_b16 %3, %11 offset:%19\n\t"
                 "ds_read_b64_tr_b16 %4, %12 offset:%20\n\tds_read_b64_tr_b16 %5, %13 offset:%21\n\tds_read_b64_tr_b16 %6, %14 offset:%22\n\tds_read_b64_tr_b16 %7, %15 offset:%23\n\ts_waitcnt lgkmcnt(0)"
                 : "=&v"(o[0]), "=&v"(o[1]), "=&v"(o[2]), "=&v"(o[3]), "=&v"(o[4]), "=&v"(o[5]), "=&v"(o[6]), "=&v"(o[7])
                 : "v"(a0), "v"(a1), "v"(a2), "v"(a3), "v"(a4), "v"(a5), "v"(a6), "v"(a7), "i"(O0), "i"(O1), "i"(O2), "i"(O3), "i"(O4), "i"(O5), "i"(O6), "i"(O7) : "memory");
}
__device__ __forceinline__ unsigned lds_u32(const LAS unsigned char* p) { return (unsigned)(unsigned long)p; }
__device__ __forceinline__ bf16x8 cat8(s16x4 a, s16x4 b) { return (bf16x8){a[0], a[1], a[2], a[3], b[0], b[1], b[2], b[3]}; }
__device__ __forceinline__ bf16x8 pack8(const f32x4 a, const f32x4 b) {
    const unsigned x = cvt_pk_bf16(a[0], a[1]), y = cvt_pk_bf16(a[2], a[3]), z = cvt_pk_bf16(b[0], b[1]), w = cvt_pk_bf16(b[2], b[3]);
    return __builtin_bit_cast(bf16x8, (v4u){x, y, z, w});
}
__device__ __forceinline__ bf16x8 scale8(const bf16x8 v, const f32x4 s0, const f32x4 s1) {
    const v4u u = __builtin_bit_cast(v4u, v);
    const unsigned x = cvt_pk_bf16(bf_lo(u.x) * s0[0], bf_hi(u.x) * s0[1]), y = cvt_pk_bf16(bf_lo(u.y) * s0[2], bf_hi(u.y) * s0[3]);
    const unsigned z = cvt_pk_bf16(bf_lo(u.z) * s1[0], bf_hi(u.z) * s1[1]), w = cvt_pk_bf16(bf_lo(u.w) * s1[2], bf_hi(u.w) * s1[3]);
    return __builtin_bit_cast(bf16x8, (v4u){x, y, z, w});
}
__device__ __forceinline__ float dot8(const bf16x8 v, const f32x4 s0, const f32x4 s1) {
    const v4u u = __builtin_bit_cast(v4u, v);
    return (bf_lo(u.x) * s0[0] + bf_hi(u.x) * s0[1]) + (bf_lo(u.y) * s0[2] + bf_hi(u.y) * s0[3]) + (bf_lo(u.z) * s1[0] + bf_hi(u.z) * s1[1]) + (bf_lo(u.w) * s1[2] + bf_hi(u.w) * s1[3]);
}
#define MFMA16(a, b, c) __builtin_amdgcn_mfma_f32_16x16x32_bf16(a, b, c, 0, 0, 0)
#define GLDS16(src, dst) __builtin_amdgcn_global_load_lds((const unsigned*)(src), (LAS unsigned*)(dst), 16, 0, 0)

template <bool PASSC>
__device__ __forceinline__ void dma_chunk(LAS unsigned char* lds, int buf, const bf16* QKV, size_t rowbase, int h, int w, int lane) {
    typedef Lay<PASSC> L;
    const int rr = lane >> 4, pos = lane & 15;
#pragma unroll
    for (int i = 0; i < 2; ++i) { const int r0 = 4 * (2 * w + i), row = r0 + rr; const unsigned sch = pos ^ swz(row);
        const bf16* src = QKV + (rowbase + row) * 2048 + h * 128 + 8 * sch;
        if (PASSC) GLDS16(src, lds + buf * L::BUFB + L::Q + 256 * r0);
        GLDS16(src + 512, lds + buf * L::BUFB + L::K + 256 * r0); }
#pragma unroll
    for (int i = 0; i < 4; ++i) { const int pc = 4 * w + i, img = pc >> 4, r0 = 4 * (pc & 15), row = r0 + rr; const unsigned sch = pos ^ swz(row);
        GLDS16(QKV + (rowbase + row) * 2048 + 1024 + h * 256 + img * 128 + 8 * sch, lds + buf * L::BUFB + L::V + img * 16384 + 256 * r0); }
}

template <bool PASSC>
__device__ __forceinline__ void dma_chunk2(LAS unsigned char* lds, int buf, const bf16* QKV, size_t rowbase, int h, int w, unsigned dq0, unsigned dv0) {
    typedef Lay<PASSC> L;
    const unsigned char* qb = (const unsigned char*)(QKV + rowbase * 2048 + h * 128);
    const unsigned char* vb = qb + h * 256;
#pragma unroll
    for (int i = 0; i < 2; ++i) { const int r0 = 4 * (2 * w + i); const unsigned o = i == 0 ? dq0 : (dq0 ^ 16u) + 16384u;
        if (PASSC) GLDS16(qb + o, lds + buf * L::BUFB + L::Q + 256 * r0);
        GLDS16(qb + o + 1024, lds + buf * L::BUFB + L::K + 256 * r0); }
#pragma unroll
    for (int i = 0; i < 4; ++i) { const int pc = 4 * w + i, img = pc >> 4, r0 = 4 * (pc & 15); const unsigned o = (dv0 ^ (unsigned)(16 * i)) + 16384u * i;
        GLDS16(vb + o, lds + buf * L::BUFB + L::V + img * 16384 + 256 * r0); }
}

template <bool PASSC>
__device__ __forceinline__ void unit(Frame& F, const int l, const int un, const int abl = 0) {
    typedef Lay<PASSC> L;
    LAS unsigned char* lds = F.lds; LAS float* sc = (LAS float*)(lds + L::SC); LAS float* sm = sc + L::SM;
    int tid0 = F.tid; asm volatile("" : "+v"(tid0)); const int w = F.wave;
    const int seg = un & (NSEG - 1), bh = un >> 2, b = bh >> 2, h = bh & 3;
    const bf16* QKV = (const bf16*)(F.ws + WS_QKV); bf16* MIX = (bf16*)(F.ws + WS_MIX); bf16* MIXO = abl ? (bf16*)(F.ws + WS_OUT) - 1024 * 0 : MIX;
    const float* LF = (const float*)(F.ws + WS_LF); const float* LI = (const float*)(F.ws + WS_LI);
    float* SEGC = (float*)(F.ws + WS_SEGC); float* SEGN = (float*)(F.ws + WS_SEGN); float* SEGS = (float*)(F.ws + WS_SEGS);
    const size_t row00 = (size_t)b * SEQ + (size_t)seg * CPS * CHUNK;
    const size_t g00 = (size_t)bh * SEQ + (size_t)seg * CPS * CHUNK;

    int tid = tid0, lane = tid0 & 63, fr = lane & 15, fq = lane >> 4;
#ifdef PROBE
#define USTAMP(i) do { if (PASSC && l == 1 && blockIdx.x == PROBE_BLK && threadIdx.x == 0) ((volatile LAS unsigned long long*)(F.lds + MISC_OFF + 64))[30 + (i)] = wall_clock64(); } while (0)
#else
#define USTAMP(i) do {} while (0)
#endif
    USTAMP(0);
    __syncthreads();
    dma_chunk<PASSC>(lds, 0, QKV, row00, h, w, lane);
    if (!PASSC) dma_chunk<PASSC>(lds, 1, QKV, row00 + CHUNK, h, w, lane);
    f32x4 C[8][2];
#pragma unroll
    for (int dt = 0; dt < 8; ++dt) { C[dt][0] = (f32x4){0.f, 0.f, 0.f, 0.f}; C[dt][1] = C[dt][0]; }
    float nreg = 0.f, m = PASSC ? 0.f : -1e30f;
    if (PASSC) {
        v4u cw[NSEG - 1][8]; float sbj[NSEG - 1], mlj[NSEG - 1], nj[NSEG - 1];
#pragma unroll
        for (int j = 0; j < NSEG - 1; ++j) if (j < seg) {
            const int uj = bh * NSEG + j; sbj[j] = SEGS[uj * 4 + 0]; mlj[j] = SEGS[uj * 4 + 1]; nj[j] = SEGN[uj * 128 + 16 * w + fr];
            const unsigned* cp = (const unsigned*)SEGC + (size_t)uj * 16384 + (size_t)w * 2048 + lane * 4;
#pragma unroll
            for (int dt = 0; dt < 8; ++dt) cw[j][dt] = *(const GAS v4u*)(cp + dt * 256); }
#pragma unroll
        for (int j = 0; j < NSEG - 1; ++j) if (j < seg) {
            const float mn = fmaxf(m + sbj[j], mlj[j]), fa = __expf(m + sbj[j] - mn), fb = __expf(mlj[j] - mn);
#pragma unroll
            for (int dt = 0; dt < 8; ++dt) { const v4u q = cw[j][dt];
                const f32x4 c0 = (f32x4){bf_lo(q.x), bf_hi(q.x), bf_lo(q.y), bf_hi(q.y)}, c1 = (f32x4){bf_lo(q.z), bf_hi(q.z), bf_lo(q.w), bf_hi(q.w)};
                C[dt][0] = C[dt][0] * fa + c0 * fb; C[dt][1] = C[dt][1] * fa + c1 * fb; }
            nreg = nreg * fa + nj[j] * fb;
            m = mn; }
        if (fq == 0) sm[NV + 16 * w + fr] = nreg;
    }
    float pj[2], cmj[2], bLj[2];
#pragma unroll
    for (int j = 0; j < 2; ++j) { const int c = 2 * w + j; const float lf = LF[g00 + c * CHUNK + lane], li = LI[g00 + c * CHUNK + lane];
        float bb = lf;
#pragma unroll
        for (int o = 1; o < 64; o <<= 1) { const float t = __shfl_up(bb, o); if (lane >= o) bb += t; }
        const float p = li - bb; float cm = p;
#pragma unroll
        for (int o = 1; o < 64; o <<= 1) { const float t = __shfl_up(cm, o); if (lane >= o) cm = fmaxf(cm, t); }
        pj[j] = p; cmj[j] = cm; bLj[j] = __shfl(bb, 63);
        if (PASSC) { sc[SP + c * 64 + lane] = p; sc[SB + c * 64 + lane] = bb; }
        if (lane == 63) { sm[BLS + c] = bb; sm[CML + c] = cm; } }
    __syncthreads();
    float sum_bL = 0.f;
    if (w == 0) {
        float mm_ = m;
        for (int c = 0; c < CPS; ++c) { const float bL = sm[BLS + c], cmL = sm[CML + c], mn = fmaxf(bL + mm_, bL + cmL);
            if (lane == 0) { sm[MST + c] = mm_; sm[DEC + c] = __expf(bL + mm_ - mn); }
            mm_ = mn; sum_bL += bL; }
        if (lane == 0) sm[MST + CPS] = mm_;
        m = mm_;
    }
    __syncthreads();
#pragma unroll
    for (int j = 0; j < 2; ++j) { const int c = 2 * w + j; const float m0 = sm[MST + c], m1 = sm[MST + c + 1];
        if (PASSC) sc[SMM + c * 64 + lane] = fmaxf(m0, cmj[j]);
        sc[L::SW + c * 64 + lane] = __expf(bLj[j] + pj[j] - m1); }
    f32x4 gh[2];
    const int gq = ((fq & 1) << 1) | (fq >> 1);
    if (PASSC) { gh[0] = *(const GAS f32x4*)(F.head_norm + l * D + h * 256 + 32 * w + 4 * gq); gh[1] = *(const GAS f32x4*)(F.head_norm + l * D + h * 256 + 32 * w + 16 + 4 * gq); }

    v4u graw[4];
    if (PASSC) {
#pragma unroll
        for (int tt = 0; tt < 4; ++tt) graw[tt] = *(const GAS v4u*)(MIX + (row00 + 16 * tt + fr) * 2048 + h * 256 + 32 * w + 16 * (fq >> 1) + 8 * (fq & 1));
    }
    unsigned kt0, vt0, lpS, spw, qn0, bi0, bpr, fr4, goff, dq0, dv0;
    { const unsigned l0 = (unsigned)tid0 & 63u, fr0 = l0 & 15u, fq0 = l0 >> 4, f_ = fr0 & 3u, x_ = fr0 >> 2, g1_ = fq0 >> 1, h1_ = fq0 & 1u, y_ = fr0 >> 1;
      lpS = 256u * fr0 + 64u * f_ + 16u * (fq0 ^ x_);
      bi0 = 256u * fr0 + 64u * f_ + 16u * (g1_ ^ x_) + 8u * h1_;
      spw = L_P + 128u * (16u * (unsigned)(w >> 1) + fr0) + 8u * h1_ + 16u * ((4u * (unsigned)(w & 1) + g1_) ^ y_);
      bpr = L_P + 128u * fr0 + 64u * (y_ >> 2) + 16u * (fq0 ^ (y_ & 3u));
      { const unsigned t1 = (unsigned)tid0 >> 3, part = (unsigned)tid0 & 7u; qn0 = 256u * t1 + 16u * ((2u * part) ^ swz(t1)); }
      fr4 = 4u * fr0;
      goff = 4096u * fr0 + 32u * g1_ + 16u * h1_;
      { const unsigned rr = l0 >> 4, pos = l0 & 15u;
        dq0 = (8u * (unsigned)w + rr) * 4096u + 16u * (pos ^ (rr << 2) ^ ((2u * (unsigned)w) & 3u));
        dv0 = (4u * ((4u * (unsigned)w) & 15u) + rr) * 4096u + 2048u + (unsigned)(w >> 2) * 256u + 16u * (pos ^ (rr << 2)); } }
    { const unsigned l0 = (unsigned)tid0 & 63u, g_ = l0 >> 4, q_ = (l0 & 15u) >> 2, p_ = l0 & 3u, Lx = (q_ << 1) | (g_ & 1u), pv = ((p_ & 1u) << 1) | (p_ >> 1);
      kt0 = lds_u32(lds) + L::K + 256u * (8u * g_ + q_) + 32u * Lx + 16u * (p_ >> 1) + 8u * (p_ & 1u);
      vt0 = lds_u32(lds) + L::V + (unsigned)(w >> 2) * 16384u + 256u * (8u * g_ + q_) + 32u * ((2u * (unsigned)(w & 3)) ^ Lx) + 16u * (pv >> 1) + 8u * (pv & 1u); }
    USTAMP(1);
    for (int c = 0; c < CPS; ++c) {
        asm volatile("" : "+v"(kt0), "+v"(vt0), "+v"(lpS), "+v"(spw), "+v"(qn0), "+v"(bi0), "+v"(bpr), "+v"(fr4), "+v"(goff), "+v"(dq0), "+v"(dv0));
        if (c == 8) USTAMP(2);
        { int t_ = tid0; asm volatile("" : "+v"(t_)); tid = t_; lane = t_ & 63; fr = lane & 15; fq = lane >> 4; }
        const size_t rowb = row00 + (size_t)c * CHUNK;
        const unsigned bufo = (unsigned)(PASSC ? (c & 1) : (c % 3)) * (unsigned)L::BUFB;
        const LAS unsigned char* sccb = (const LAS unsigned char*)(sc + c * 64) + fr4;
        const LAS unsigned char* smb = (const LAS unsigned char*)sm + fr4;
        LAS float* scc = sc + c * 64;
        if (PASSC) { if (c == 0) asm volatile("s_waitcnt vmcnt(0) lgkmcnt(0)" ::: "memory");
                     else asm volatile("s_waitcnt vmcnt(8) lgkmcnt(0)" ::: "memory"); }
        else if (c + 1 >= CPS) asm volatile("s_waitcnt vmcnt(0) lgkmcnt(0)" ::: "memory");
        else asm volatile("s_waitcnt vmcnt(6) lgkmcnt(0)" ::: "memory");
        __builtin_amdgcn_s_barrier();
        asm volatile("" ::: "memory");
        if (c == 8) USTAMP(4);
        if (c == 9) USTAMP(7);
        f32x4 Y[4][2];
        if (PASSC) { if (c + 1 < CPS && !(abl & 128)) dma_chunk2<PASSC>(lds, (c + 1) & 1, QKV, rowb + CHUNK, h, w, dq0, dv0); }
        else { if (c + 2 < CPS) dma_chunk2<PASSC>(lds, (c + 2) % 3, QKV, rowb + 2 * CHUNK, h, w, dq0, dv0); }
        const float mc0 = sm[MST + c];
        if (PASSC) {
            if (!(abl & 16)) { const int ti = w >> 1, sh = w & 1, t = 16 * ti + fr; const float rt = -*(const LAS float*)(sccb + 4 * (SMM + 16 * ti));
              bf16x8 ka[2][4], qb[4];
              const unsigned sqa = lpS + (bufo + (unsigned)(L::Q + 4096 * ti)), ska = lpS + (bufo + (unsigned)(L::K + 8192 * sh));
#pragma unroll
              for (int ks = 0; ks < 4; ++ks) { qb[ks] = *(const LAS bf16x8*)(lds + (sqa ^ (unsigned)(64 * ks)));
                  ka[0][ks] = *(const LAS bf16x8*)(lds + (ska ^ (unsigned)(64 * ks))); ka[1][ks] = *(const LAS bf16x8*)(lds + (ska ^ (unsigned)(64 * ks)) + 4096); }
              float rsum = 0.f;
#pragma unroll
              for (int s2 = 0; s2 < 2; ++s2) { const int si = 2 * sh + s2; f32x4 a = (f32x4){0.f, 0.f, 0.f, 0.f};
#pragma unroll
                  for (int ks = 0; ks < 4; ++ks) a = MFMA16(ka[s2][ks], qb[ks], a);
                  const f32x4 ps = *(const LAS f32x4*)(scc + SP + 16 * si + 4 * fq); f32x4 pv;
#pragma unroll
                  for (int e = 0; e < 4; ++e) { const int s = 16 * si + 4 * fq + e; pv[e] = (s <= t) ? a[e] * __expf(rt + ps[e]) : 0.f; }
                  rsum += (pv[0] + pv[1]) + (pv[2] + pv[3]);
                  v2u pk; pk.x = cvt_pk_bf16(pv[0], pv[1]); pk.y = cvt_pk_bf16(pv[2], pv[3]);
                  *(LAS v2u*)(lds + (spw ^ (unsigned)(32 * s2))) = pk; }
              rsum = xadd32(xadd16(rsum));
              if (fq == 0) *(LAS float*)((LAS unsigned char*)sm + fr4 + 4 * (RSP + sh * 64 + 16 * ti)) = rsum; }
            if (!(abl & 16)) { const int t = tid >> 3, part = tid & 7; float a = 0.f;
#pragma unroll
              for (int hh = 0; hh < 2; ++hh) { const v4u qv = *(const LAS v4u*)(lds + ((qn0 + (bufo + (unsigned)L::Q)) ^ (unsigned)(16 * hh)));
                  const f32x4 n0 = *(const LAS f32x4*)(sm + NV + 16 * part + 8 * hh), n1 = *(const LAS f32x4*)(sm + NV + 16 * part + 8 * hh + 4);
                  a += bf_lo(qv.x) * n0[0] + bf_hi(qv.x) * n0[1] + bf_lo(qv.y) * n0[2] + bf_hi(qv.y) * n0[3] + bf_lo(qv.z) * n1[0] + bf_hi(qv.z) * n1[1] + bf_lo(qv.w) * n1[2] + bf_hi(qv.w) * n1[3]; }
              a = DPP_ADD0(a, 0xB1); a = DPP_ADD0(a, 0x4E); a = DPP_ADD0(a, 0x104);
              if (part == 0) sm[QN + t] = a; }
#pragma unroll
            for (int tt = 0; tt < 4; ++tt) { Y[tt][0] = (f32x4){0.f, 0.f, 0.f, 0.f}; Y[tt][1] = Y[tt][0]; }
            if (!(abl & 64))
#pragma unroll
            for (int ks = 0; ks < 4; ++ks) { const bf16x8 cf0 = pack8(C[2 * ks][0], C[2 * ks + 1][0]), cf1 = pack8(C[2 * ks][1], C[2 * ks + 1][1]);
                bf16x8 qp[4];
                const unsigned qa0 = (bi0 + (bufo + (unsigned)L::Q)) ^ (unsigned)(64 * ks), qa1 = qa0 ^ 32u;
#pragma unroll
                for (int tt = 0; tt < 4; ++tt) {
                    const v2u q0 = *(const LAS v2u*)(lds + qa0 + 4096 * tt), q1 = *(const LAS v2u*)(lds + qa1 + 4096 * tt);
                    qp[tt] = __builtin_bit_cast(bf16x8, (v4u){q0.x, q0.y, q1.x, q1.y}); }
#pragma unroll
                for (int tt = 0; tt < 4; ++tt) { if (!(abl & 32)) { const f32x4 z4 = (f32x4){0.f, 0.f, 0.f, 0.f};
                        Y[tt][0] = MFMA16(cf0, qp[tt], (ks == 0 && !abl) ? z4 : Y[tt][0]); Y[tt][1] = MFMA16(cf1, qp[tt], (ks == 0 && !abl) ? z4 : Y[tt][1]); } else { Y[tt][0] += __builtin_bit_cast(f32x4, qp[tt]); } } }
        }
        const unsigned vimg = L::V + (w >> 2) * 16384, vc0 = 2 * (w & 3);
        bf16x8 VT[2][2];
        { s16x4 o[8]; const unsigned vb = vt0 + (unsigned)(PASSC ? (c & 1) : (c % 3)) * (unsigned)L::BUFB, vb16 = vb ^ 16u, vb32 = vb ^ 32u, vb48 = vb ^ 48u;
          tr_read8o<0, 1024, 8192, 9216, 0, 1024, 8192, 9216>(o, vb, vb16, vb, vb16, vb32, vb48, vb32, vb48);
#pragma unroll
          for (int vt = 0; vt < 2; ++vt)
#pragma unroll
              for (int ks = 0; ks < 2; ++ks) VT[vt][ks] = cat8(o[4 * vt + 2 * ks], o[4 * vt + 2 * ks + 1]); }
        if (PASSC) {
            LDS_WAIT(); if (!(abl & 8)) __builtin_amdgcn_s_barrier(); asm volatile("" ::: "memory");
            if (c == 8) USTAMP(5);
            bf16x8 pb[4][2];
#pragma unroll
            for (int tt = 0; tt < 4; ++tt)
#pragma unroll
                for (int ks = 0; ks < 2; ++ks) pb[tt][ks] = *(const LAS bf16x8*)(lds + (bpr ^ (unsigned)(64 * ks)) + 2048 * tt);
            float mm4[4], sb4[4], r04[4], r14[4], qn4[4];
#pragma unroll
            for (int tt = 0; tt < 4; ++tt) { mm4[tt] = *(const LAS float*)(sccb + 4 * (SMM + 16 * tt)); sb4[tt] = *(const LAS float*)(sccb + 4 * (SB + 16 * tt));
                r04[tt] = *(const LAS float*)(smb + 4 * (RSP + 16 * tt)); r14[tt] = *(const LAS float*)(smb + 4 * (RSP + 64 + 16 * tt)); qn4[tt] = *(const LAS float*)(smb + 4 * (QN + 16 * tt)); }
#pragma unroll
            for (int tt = 0; tt < 4; ++tt) { const int t = 16 * tt + fr; const float mmv = mm4[tt], iw = __expf(mc0 - mmv);
                Y[tt][0] = Y[tt][0] * iw; Y[tt][1] = Y[tt][1] * iw;
#pragma unroll
                for (int ks = 0; ks < 2; ++ks) { Y[tt][0] = MFMA16(VT[0][ks], pb[tt][ks], Y[tt][0]); Y[tt][1] = MFMA16(VT[1][ks], pb[tt][ks], Y[tt][1]); }
                const float den = r04[tt] + r14[tt] + iw * qn4[tt];
                const float hs = __builtin_amdgcn_rcpf(fmaxf(fabsf(den), __expf(-(sb4[tt] + mmv))));
                Y[tt][0] = Y[tt][0] * hs; Y[tt][1] = Y[tt][1] * hs;
                float ss = 0.f;
#pragma unroll
                for (int e = 0; e < 4; ++e) ss += Y[tt][0][e] * Y[tt][0][e] + Y[tt][1][e] * Y[tt][1][e];
                ss = xadd32(xadd16(ss));
                if (fq == 0) *(LAS float*)((LAS unsigned char*)sm + 8 * fr4 + 4 * (HN + 128 * tt + w)) = ss; }
            LDS_WAIT(); if (!(abl & 8)) __builtin_amdgcn_s_barrier(); asm volatile("" ::: "memory");
            if (c == 8) USTAMP(6);
            f32x4 hp[4][2];
#pragma unroll
            for (int tt = 0; tt < 4; ++tt) { const LAS unsigned char* hb = (const LAS unsigned char*)sm + 8 * fr4 + 4 * (HN + 128 * tt); hp[tt][0] = *(const LAS f32x4*)hb; hp[tt][1] = *(const LAS f32x4*)(hb + 16); }
#pragma unroll
            for (int tt = 0; tt < 4; ++tt) { const int t = 16 * tt + fr;
                const f32x4 hs4 = hp[tt][0] + hp[tt][1]; const float tot = (hs4[0] + hs4[1]) + (hs4[2] + hs4[3]);
                const float rn = rsqrtf(tot * (1.0f / 256.0f) + EPS);
                const auto g0 = __builtin_amdgcn_permlane32_swap(graw[tt].x, graw[tt].z, false, false), g1 = __builtin_amdgcn_permlane32_swap(graw[tt].y, graw[tt].w, false, false);
                const f32x4 y0 = Y[tt][0] * rn * gh[0], y1 = Y[tt][1] * rn * gh[1];
                const unsigned o0x = cvt_pk_bf16(y0[0] * bf_lo(g0[0]), y0[1] * bf_hi(g0[0])), o0y = cvt_pk_bf16(y0[2] * bf_lo(g1[0]), y0[3] * bf_hi(g1[0]));
                const unsigned o1x = cvt_pk_bf16(y1[0] * bf_lo(g0[1]), y1[1] * bf_hi(g0[1])), o1y = cvt_pk_bf16(y1[2] * bf_lo(g1[1]), y1[3] * bf_hi(g1[1]));
                const auto sx = __builtin_amdgcn_permlane32_swap(o0x, o1x, false, false), sy = __builtin_amdgcn_permlane32_swap(o0y, o1y, false, false);
                v4u ov; ov.x = sx[0]; ov.y = sy[0]; ov.z = sx[1]; ov.w = sy[1];
                if (!abl) *(GAS v4u*)((unsigned char*)(MIX + rowb * 2048 + h * 256 + 32 * w) + (goff + 65536u * tt)) = ov;
                else if (!(abl & 2) || (ov.x == 0x12345678u)) *(GAS v4u*)(MIXO + ((rowb + t) * 2048 + h * 256 + 32 * w + 16 * (fq >> 1) + 8 * (fq & 1)) % (size_t)(64u << 20)) = ov; }
            if (c + 1 < CPS && !(abl & 2)) {
#pragma unroll
                for (int tt = 0; tt < 4; ++tt) graw[tt] = *(const GAS v4u*)((const unsigned char*)(MIX + (rowb + CHUNK) * 2048 + h * 256 + 32 * w) + (goff + 65536u * tt));
            }
        }
        if (!(abl & 256)) { const float decay = sm[DEC + c]; float nsum = 0.f;
#pragma unroll
          for (int dt = 0; dt < 8; ++dt) { C[dt][0] = C[dt][0] * decay; C[dt][1] = C[dt][1] * decay; }
#pragma unroll
          for (int ks = 0; ks < 2; ++ks) {
              const f32x4 w0 = *(const LAS f32x4*)(scc + L::SW + 32 * ks + 8 * fq), w1 = *(const LAS f32x4*)(scc + L::SW + 32 * ks + 8 * fq + 4);
              const bf16x8 vw0 = scale8(VT[0][ks], w0, w1), vw1 = scale8(VT[1][ks], w0, w1);
              bf16x8 kt[8];
              { const unsigned kb = kt0 + (unsigned)(PASSC ? (c & 1) : (c % 3)) * (unsigned)L::BUFB;
#pragma unroll
                for (int hf = 0; hf < 2; ++hf) { s16x4 o[8];
                    const unsigned a0 = kb ^ (unsigned)(128 * hf), a1 = a0 ^ 32u, a2 = a0 ^ 64u, a3 = a0 ^ 96u;
                    if (ks == 0) tr_read8o<0, 1024, 0, 1024, 0, 1024, 0, 1024>(o, a0, a0 ^ 16u, a1, a1 ^ 16u, a2, a2 ^ 16u, a3, a3 ^ 16u);
                    else tr_read8o<8192, 9216, 8192, 9216, 8192, 9216, 8192, 9216>(o, a0, a0 ^ 16u, a1, a1 ^ 16u, a2, a2 ^ 16u, a3, a3 ^ 16u);
#pragma unroll
                    for (int j = 0; j < 4; ++j) kt[4 * hf + j] = cat8(o[2 * j], o[2 * j + 1]); } }
#pragma unroll
              for (int dt = 0; dt < 8; ++dt) { if (!(abl & 4)) { C[dt][0] = MFMA16(kt[dt], vw0, C[dt][0]); C[dt][1] = MFMA16(kt[dt], vw1, C[dt][1]); } if (dt == w) nsum += dot8(kt[dt], w0, w1); } }
          nsum = xadd32(xadd16(nsum));
          nreg = nreg * decay + nsum;
          if (PASSC && fq == 0) sm[NV + 16 * w + fr] = nreg; }
    }
    USTAMP(3);
    if (!PASSC) {
        unsigned* cp = (unsigned*)SEGC + (size_t)un * 16384 + (size_t)w * 2048 + lane * 4;
#pragma unroll
        for (int dt = 0; dt < 8; ++dt) { v4u o; o.x = cvt_pk_bf16(C[dt][0][0], C[dt][0][1]); o.y = cvt_pk_bf16(C[dt][0][2], C[dt][0][3]); o.z = cvt_pk_bf16(C[dt][1][0], C[dt][1][1]); o.w = cvt_pk_bf16(C[dt][1][2], C[dt][1][3]);
            *(GAS v4u*)(cp + dt * 256) = o; }
        if (fq == 0) SEGN[un * 128 + 16 * w + fr] = nreg;
        if (tid == 0) { SEGS[un * 4 + 0] = sum_bL; SEGS[un * 4 + 1] = m; }
    }
}
}

#ifdef DBG
constexpr int NLAYERS_RUN = 1;
#else
constexpr int NLAYERS_RUN = DEPTH;
#endif
struct Args { const float* in[10]; float* out; unsigned char* ws; };
#define REFRESH() do { int t_ = threadIdx.x; asm volatile("" : "+v"(t_)); F.tid = t_; F.lane = t_ & 63; } while (0)
__global__ void __launch_bounds__(NWAVES * 64, 2) hymba_fwd(Args args) {
    extern __shared__ __attribute__((aligned(16))) unsigned char lds_raw[];
    Frame F;
    F.lds = (LAS unsigned char*)lds_raw;
    F.tid = threadIdx.x; F.lane = F.tid & 63; F.wave = __builtin_amdgcn_readfirstlane(F.tid >> 6);
    F.G = gridDim.x; { const int bx = blockIdx.x; F.vcu = (F.G % 8 == 0) ? (bx % 8) * (F.G / 8) + bx / 8 : bx; }
    F.x = args.in[0]; F.norm_pre = args.in[1]; F.norm_post = args.in[2]; F.w_in = args.in[3]; F.b_i = args.in[4]; F.b_f = args.in[5];
    F.head_norm = args.in[6]; F.conv_w = args.in[7]; F.conv_norm = args.in[8]; F.w_out = args.in[9]; F.out = args.out; F.ws = args.ws;
    volatile LAS unsigned* MISC = (volatile LAS unsigned*)(F.lds + MISC_OFF);
    if (F.tid < 4) MISC[F.tid] = 0u;
    __syncthreads();
    XcdBarrier bar = xcd_barrier_post((unsigned*)(F.ws + WS_CTL) + CW_BAR, MISC);
#ifdef PROBE
#ifndef PROBE_BLK
#define PROBE_BLK 0
#endif
    volatile LAS unsigned long long* STAMPS = (volatile LAS unsigned long long*)(F.lds + MISC_OFF + 64);
    int n_st = 0;
#define STAMP() do { if (blockIdx.x == PROBE_BLK && threadIdx.x == 0 && n_st < 40) STAMPS[n_st] = wall_clock64(); ++n_st; } while (0)
    STAMP();
#else
#define STAMP() do {} while (0)
#endif

#ifndef NO_PREP
    REFRESH(); prep_phase(F);
    __syncthreads();
#endif
#ifndef NO_THIN
    REFRESH(); thin_phase(F, 0, true);
#endif
    xcd_barrier(bar); STAMP();
#pragma unroll 1
    for (int l = 0; l < NLAYERS_RUN; ++l) {
#ifndef NO_G1
        {
            pg8::Gemm g{(const pg8::bf16_t*)(F.ws + WS_XB), (const pg8::bf16_t*)(F.ws + WS_BT1) + (size_t)l * N1 * D, MTOK, N1, D};
            Order1 S; S.init(F.G, (int)blockIdx.x);
#ifdef G1_STAGGER
            { const unsigned long long t0 = wall_clock64(), dl = (unsigned long long)(((blockIdx.x >> 3) & 31) * G1_STAGGER);
              while (wall_clock64() - t0 < dl) __builtin_amdgcn_s_sleep(4); }
#endif
            LAS float* cwl = (LAS float*)(F.lds + CONVW_OFF);
            REFRESH();
#pragma unroll
            for (int i = 0; i < 2; ++i) { const int idx = F.tid + 512 * i;
                const float* src = idx < 768 ? F.conv_w + (size_t)l * 3 * DCONV + 4 * idx : F.conv_norm + (size_t)l * DCONV + 4 * (idx - 768);
                f32x4 v = *(const GAS f32x4*)src; if (idx >= 768) v = v * -0.6931471805599453f;
                *(LAS f32x4*)(cwl + 4 * idx) = v; }
            Epi1 E{(bf16*)(F.ws + WS_QKV), (bf16*)(F.ws + WS_MIX), (const float*)(F.ws + WS_RSTD), cwl,
                   (float*)(F.ws + WS_FIX), F.lds + EPI_OFF, (bf16*)(F.ws + WS_DBG), 0, false};
#if defined(PROBE) && defined(ABL_EPI)
            { Epi1 E2 = E; E2.mode = (ABL_EPI >= 10) ? 0 : ABL_EPI; E2.skipst = (ABL_EPI == 11) && (((const unsigned*)(F.ws + WS_CTL))[8] == 0u);
              pg8::gemm_phase<Epi1, Order1, true, true>(F.lds, g, S, E2); __syncthreads(); }
#endif
            pg8::gemm_phase<Epi1, Order1, true, true>(F.lds, g, S, E);
        }
#endif
        xcd_barrier(bar); STAMP();
#ifndef NO_MA
        REFRESH(); conv_fixup(F, l); REFRESH();
#if defined(PROBE) && defined(MA_TWICE)
        for (int un = blockIdx.x; un < NUNIT; un += F.G) ml::unit<false>(F, l, un);
#endif
#if defined(PROBE) && defined(FIX_TWICE)
        conv_fixup(F, l); conv_fixup(F, l); conv_fixup(F, l); conv_fixup(F, l);
#endif
        for (int un = blockIdx.x; un < NUNIT; un += F.G) ml::unit<false>(F, l, un);
#endif
        xcd_barrier(bar); STAMP();
#ifndef NO_MC
        REFRESH();
#if defined(PROBE) && defined(MC_DRY)
        for (int un = blockIdx.x; un < NUNIT; un += F.G) ml::unit<true>(F, l, un, MC_DRY);
#endif
        for (int un = blockIdx.x; un < NUNIT; un += F.G) ml::unit<true>(F, l, un);
#endif
        xcd_barrier(bar); STAMP();
#ifndef NO_G2
        {
            pg8::Gemm g{(const pg8::bf16_t*)(F.ws + WS_MIX), (const pg8::bf16_t*)(F.ws + WS_BT2) + (size_t)l * D * DMIX, MTOK, D, DMIX};
            pg8::StaticOrder S; S.init(MTOK, D, F.G, (int)blockIdx.x);
            Epi2 E{(bf16*)(F.ws + WS_OUT)};
#if defined(PROBE) && defined(G2_TWICE)
            pg8::gemm_phase<Epi2, pg8::StaticOrder, true, true>(F.lds, g, S, E); __syncthreads();
#endif
            pg8::gemm_phase<Epi2, pg8::StaticOrder, true, true>(F.lds, g, S, E);
        }
#endif
        xcd_barrier(bar); STAMP();
#ifndef NO_THIN
        REFRESH(); thin_phase(F, l + 1, l + 1 < NLAYERS_RUN);
#endif
        if (l + 1 < NLAYERS_RUN) xcd_barrier(bar); STAMP();
    }
#ifdef PROBE
    if (blockIdx.x == PROBE_BLK && threadIdx.x == 0) {
        asm volatile("s_waitcnt vmcnt(0)" ::: "memory");
        const unsigned long long da = STAMPS[PROBE_A1] - STAMPS[PROBE_A0];
#ifdef PROBE_FIXED
        const unsigned long long ds = PROBE_FIXED;
#else
        const unsigned long long ds = STAMPS[PROBE_S1] - STAMPS[PROBE_S0];
#endif
#ifdef PROBE_Q
        F.out[0] = (float)((da / PROBE_Q) * PROBE_Q) * 0.01f * (float)PROBE_SCALE;
#else
        F.out[0] = ((float)da * 0.01f - (float)PROBE_OFF) * (float)PROBE_SCALE;
#endif
        const unsigned long long t0 = wall_clock64(); while (wall_clock64() - t0 < (unsigned long long)PROBE_MUL * ds) __builtin_amdgcn_s_sleep(8);
    }
#endif
}

#ifdef DBG
constexpr size_t DBG_RES = 40960;
__device__ __forceinline__ float dbg_bf(bf16 v) { return __builtin_bit_cast(float, (unsigned)v << 16); }
__device__ float dbg_bsum(float v, float* sh) {
    __syncthreads(); sh[threadIdx.x] = v; __syncthreads();
    for (int o = 128; o > 0; o >>= 1) { if ((int)threadIdx.x < o) sh[threadIdx.x] += sh[threadIdx.x + o]; __syncthreads(); }
    const float r = sh[0]; __syncthreads(); return r;
}
__device__ float dbg_rstd(const float* xrow, float* sh) { float s = 0.f; for (int k = threadIdx.x; k < D; k += 256) s += xrow[k] * xrow[k]; return rsqrtf(dbg_bsum(s, sh) * (1.0f / D) + EPS); }
__device__ float dbg_dot(const float* xrow, const float* gp, const float* W, int col, float* sh) {
    float s = 0.f; for (int k = threadIdx.x; k < D; k += 256) s += xrow[k] * gp[k] * W[(size_t)k * INCOLS + col]; return dbg_bsum(s, sh);
}
__device__ void dbg_acc(float* res, int bit, float e2, float r2) { if (threadIdx.x == 0) { atomicAdd(res + bit, e2); atomicAdd(res + 16 + bit, r2); } }
constexpr int DBG_N1 = 48, DBG_N2 = 24, DBG_NG = 16, DBG_N3 = 12, DBG_N4 = 8, DBG_N5 = 32;
__global__ void __launch_bounds__(256) dbg_check(Args a) {
    __shared__ float sh[256]; __shared__ float vals[3][4][64]; __shared__ float Fc[4096]; __shared__ float scs[4096]; __shared__ float tot[256];
    const float* x = a.in[0]; const float* gp = a.in[1]; const float* W = a.in[3]; const float* cw = a.in[7]; const float* cg = a.in[8];
    float* res = (float*)(a.ws + WS_CTL + DBG_RES);
    const bf16* QKV = (const bf16*)(a.ws + WS_QKV); const bf16* MIX = (const bf16*)(a.ws + WS_MIX); const bf16* DBGG = (const bf16*)(a.ws + WS_DBG);
    const float* LI = (const float*)(a.ws + WS_LI); const float* LF = (const float*)(a.ws + WS_LF);
    int id = blockIdx.x; const int tid = threadIdx.x;
    if (id < DBG_N1) {
        const int i = id, r = (int)(((unsigned)i * 7919u + 13u) & 65535u), pn = i & 7, ci = (i * 37 + 5) & 255, cc = 256 * pn + ci;
        const float rs = dbg_rstd(x + (size_t)r * D, sh);
        const float ref = dbg_dot(x + (size_t)r * D, gp, W, cc, sh) * rs * (cc < 512 ? 0.08838834764831845f : 1.0f);
        const float val = dbg_bf(QKV[(size_t)r * 2048 + cc]);
        dbg_acc(res, 0, (val - ref) * (val - ref), ref * ref); return;
    }
    id -= DBG_N1;
    if (id < DBG_N2) {
        const int i = id, r = (int)(((unsigned)i * 104729u + 77u) & 65535u), ch = (i * 131 + 9) & 1023;
        const float rs = dbg_rstd(x + (size_t)r * D, sh);
        const float o = dbg_dot(x + (size_t)r * D, gp, W, 2048 + ch, sh) * rs, z = dbg_dot(x + (size_t)r * D, gp, W, 3072 + ch, sh) * rs;
        const float ref = z / (1.f + expf(-z)) / (1.f + expf(-o));
        const float val = dbg_bf(DBGG[(size_t)r * 1024 + ch]);
        dbg_acc(res, 0, (val - ref) * (val - ref), ref * ref); return;
    }
    id -= DBG_N2;
    if (id < DBG_NG) {
        const int i = id, r = (int)(((unsigned)i * 31337u + 5u) & 65535u), h = i & 3, b = r >> 12, t = r & 4095;
        const float rs = dbg_rstd(x + (size_t)r * D, sh);
        const float ip = dbg_dot(x + (size_t)r * D, gp, W, 4096 + h, sh) * rs + a.in[4][h], fp = dbg_dot(x + (size_t)r * D, gp, W, 4100 + h, sh) * rs + a.in[5][h];
        const float lfr = fminf(fp, 0.f) - log1pf(expf(-fabsf(fp)));
        const float v1 = LI[(size_t)(b * 4 + h) * SEQ + t], v2 = LF[(size_t)(b * 4 + h) * SEQ + t];
        dbg_acc(res, 0, (v1 - ip) * (v1 - ip) + (v2 - lfr) * (v2 - lfr), ip * ip + lfr * lfr); return;
    }
    id -= DBG_NG;
    if (id < 5 * DBG_N3) {
        const int cat = id / DBG_N3, i = id % DBG_N3, g = (i * 5 + cat) & 15;
        int rb = (int)(((unsigned)(i + 1) * 2654435761u >> 8) & 65535u) & ~255, off;
        if (cat == 0) off = 5 + (i % 10);
        else if (cat == 1) off = 16 * (1 + i % 3) + (i & 1);
        else if (cat == 2) off = 64 * (1 + i % 3) + (i & 1);
        else if (cat == 3) { off = (i & 1); if (((rb >> 8) & 15) == 0) rb += 256; }
        else { rb &= ~4095; off = (i & 1); }
        const int r = rb + off, t = r & (SEQ - 1), qn = tid >> 6, c = tid & 63, col = 4104 + 1024 * qn + 64 * g + c;
        for (int j = 0; j < 3; ++j) {
            const int tj = t - 2 + j; float v = 0.f;
            if (tj >= 0) { const float* xr = x + (size_t)(r - 2 + j) * D; const float rs = dbg_rstd(xr, sh);
                float s = 0.f; for (int k = 0; k < D; ++k) s += xr[k] * gp[k] * W[(size_t)k * INCOLS + col]; v = s * rs; }
            vals[j][qn][c] = v;
        }
        __syncthreads();
        float y = 0.f, bc = 0.f;
        if (qn == 0) { const int ch = 64 * g + c;
            const float cu0 = vals[0][0][c] * vals[0][2][c], cu1 = vals[1][0][c] * vals[1][2][c], cu2 = vals[2][0][c] * vals[2][2][c];
            bc = vals[2][1][c] * (cw[ch] * cu0 + cw[1024 + ch] * cu1 + cw[2048 + ch] * cu2); }
        const float ss = dbg_bsum(qn == 0 ? bc * bc : 0.f, sh);
        float e2 = 0.f, r2 = 0.f;
        if (qn == 0) { const int ch = 64 * g + c; const float z = vals[2][3][c]; y = z / (1.f + expf(-z)) * bc * rsqrtf(ss * (1.0f / 64.0f) + EPS) * cg[ch];
            const float val = dbg_bf(MIX[(size_t)r * 2048 + 1024 + ch]); e2 = (val - y) * (val - y); r2 = y * y; }
        e2 = dbg_bsum(e2, sh); r2 = dbg_bsum(r2, sh);
        dbg_acc(res, cat < 3 ? 1 : 2, e2, r2); return;
    }
    id -= 5 * DBG_N3;
    if (id < 3 * DBG_N4) {
        const int cat = id / DBG_N4, i = id % DBG_N4, bh = (i * 13 + cat * 7) & 63, b = bh >> 2, h = bh & 3;
        int t;
        if (cat == 0) { const int tt[8] = {0, 1, 5, 17, 31, 37, 62, 63}; t = tt[i]; }
        else if (cat == 1) { const int tt[8] = {64, 65, 100, 127, 128, 500, 1000, 1023}; t = tt[i]; }
        else { const int tt[8] = {1024, 1025, 1500, 2047, 2048, 3000, 3071, 4095}; t = tt[i]; }
        const size_t rbase = (size_t)b * SEQ, r = rbase + t;
        { float run = 0.f; for (int j = 0; j < 16; ++j) { run += LF[(size_t)bh * SEQ + tid * 16 + j]; Fc[tid * 16 + j] = run; } tot[tid] = run; }
        __syncthreads();
        if (tid == 0) { float run = 0.f; for (int j = 0; j < 256; ++j) { const float v = tot[j]; tot[j] = run; run += v; } }
        __syncthreads();
        for (int j = 0; j < 16; ++j) Fc[tid * 16 + j] += tot[tid];
        __syncthreads();
        const float Ft = Fc[t];
        float dsum = 0.f;
        for (int s = tid; s <= t; s += 256) { float d = 0.f;
            for (int k = 0; k < 128; ++k) d += dbg_bf(QKV[r * 2048 + h * 128 + k]) * dbg_bf(QKV[(rbase + s) * 2048 + 512 + h * 128 + k]);
            const float w = expf(Ft - Fc[s] + LI[(size_t)bh * SEQ + s]) * d; scs[s] = w; dsum += w; }
        const float den = dbg_bsum(dsum, sh);
        float num = 0.f;
        for (int s = 0; s <= t; ++s) num += scs[s] * dbg_bf(QKV[(rbase + s) * 2048 + 1024 + h * 256 + tid]);
        const float hv = num / fmaxf(fabsf(den), 1.0f);
        const float ssq = dbg_bsum(hv * hv, sh);
        const float ref = dbg_bf(DBGG[r * 1024 + h * 256 + tid]) * hv * rsqrtf(ssq * (1.0f / 256.0f) + EPS) * a.in[6][h * 256 + tid];
        const float val = dbg_bf(MIX[r * 2048 + h * 256 + tid]);
        const float e2 = dbg_bsum((val - ref) * (val - ref), sh), r2 = dbg_bsum(ref * ref, sh);
        dbg_acc(res, 3 + cat, e2, r2); return;
    }
    id -= 3 * DBG_N4;
    if (id < DBG_N5) {
        const int i = id, r = (int)(((unsigned)i * 48271u + 11u) & 65535u), c = (i * 173 + 3) & 1023;
        const bf16* OUTB = (const bf16*)(a.ws + WS_OUT);
        float s = 0.f; for (int k = tid; k < DMIX; k += 256) s += dbg_bf(MIX[(size_t)r * 2048 + k]) * a.in[9][(size_t)k * D + c];
        const float ref = dbg_bsum(s, sh), val = dbg_bf(OUTB[(size_t)r * D + c]);
        float q = 0.f; for (int k = tid; k < D; k += 256) { const float o = dbg_bf(OUTB[(size_t)r * D + k]); q += o * o; }
        const float rs = rsqrtf(dbg_bsum(q, sh) * (1.0f / D) + EPS);
        const float ref2 = x[(size_t)r * D + c] + val * rs * a.in[2][c], val2 = a.out[(size_t)r * D + c];
        dbg_acc(res, 6, (val - ref) * (val - ref) + (val2 - ref2) * (val2 - ref2), ref * ref + ref2 * ref2); return;
    }
}
__global__ void __launch_bounds__(256) dbg_report(Args a) {
    const float* res = (const float*)(a.ws + WS_CTL + DBG_RES);
    int mask = 0;
    for (int i = 0; i < 7; ++i) { const float e = res[i], r = res[16 + i]; if (!(e <= 0.0025f * r) || !(r > 0.f)) mask |= 1 << i; }
    const size_t n = (size_t)MTOK * D;
    for (size_t i = (size_t)blockIdx.x * 256 + threadIdx.x; i < n; i += (size_t)gridDim.x * 256) a.out[i] = 0.f;
    if (blockIdx.x == 0 && threadIdx.x == 0) a.out[0] = ldexpf(1.0f, (mask < 120 ? mask : 120) + 4);
}
#endif
extern "C" void kernel_launch(void* const* d_in, const int* in_sizes, int n_in, void* d_out, int out_size, void* d_ws, size_t ws_size, hipStream_t stream) {
    static int grid = 0;
    if (grid == 0) {
        if (n_in != 10 || out_size != MTOK * D || ws_size < WS_END) { fprintf(stderr, "kernel_launch: unexpected shapes (n_in %d, out %d, ws %zu)\n", n_in, out_size, ws_size); grid = -1; return; }
        int dev = 0, cus = 0, per_cu = 0;
        if (hipGetDevice(&dev) != hipSuccess || hipDeviceGetAttribute(&cus, hipDeviceAttributeMultiprocessorCount, dev) != hipSuccess) { grid = -1; return; }
        if (hipFuncSetAttribute((const void*)hymba_fwd, hipFuncAttributeMaxDynamicSharedMemorySize, LDS_BYTES) != hipSuccess) { fprintf(stderr, "kernel_launch: hipFuncSetAttribute failed\n"); grid = -1; return; }
        if (hipOccupancyMaxActiveBlocksPerMultiprocessor(&per_cu, (const void*)hymba_fwd, NWAVES * 64, LDS_BYTES) != hipSuccess || per_cu < 1) { fprintf(stderr, "kernel_launch: occupancy query says %d\n", per_cu); grid = -1; return; }
        if (cus < 256) { fprintf(stderr, "kernel_launch: built for 256 CUs, device reports %d\n", cus); grid = -1; return; }
        grid = 256;
    }
    if (grid <= 0) return;
    if (hipMemsetAsync((char*)d_ws + WS_CTL, 0, CTL_ZERO_BYTES, stream) != hipSuccess) return;
    Args a{};
    for (int i = 0; i < 10; ++i) a.in[i] = (const float*)d_in[i];
    a.out = (float*)d_out; a.ws = (unsigned char*)d_ws;
    hipLaunchKernelGGL(hymba_fwd, dim3(grid), dim3(NWAVES * 64), LDS_BYTES, stream, a);
#ifdef DBG
    hipLaunchKernelGGL(dbg_check, dim3(DBG_N1 + DBG_N2 + DBG_NG + 5 * DBG_N3 + 3 * DBG_N4 + DBG_N5), dim3(256), 0, stream, a);
    hipLaunchKernelGGL(dbg_report, dim3(1024), dim3(256), 0, stream, a);
#endif
}
```

```cpp
#include <hip/hip_runtime.h>
#include <cstdio>
#include <cstdint>
namespace pg8 {
#define PG8_LAS __attribute__((address_space(3)))
typedef unsigned short bf16_t;
typedef short bf16x8 __attribute__((ext_vector_type(8)));
typedef float f32x4 __attribute__((ext_vector_type(4)));
typedef unsigned u32x4 __attribute__((ext_vector_type(4)));
constexpr int BM = 256, BK = 64, HALF = 128, HTB = HALF * BK * 2  , STAGE_BYTES = 8 * HTB, NXCD = 8, WGM = 8;

__host__ __device__ __forceinline__ int lds_byte(int r, int c) { const int st = (r >> 4) * 2 + (c >> 5), rr = r & 15, cc = c & 31, ob = rr * 64 + cc * 2; return st * 1024 + (ob ^ (((ob >> 9) & 1) << 5)); }
__host__ __device__ __forceinline__ void stage_rc(int b, int& R, int& C) { const int st = b / 1024, sb = b % 1024, swz = sb ^ (((sb >> 9) & 1) << 5); R = (st >> 1) * 16 + swz / 64; C = (st & 1) * 32 + (swz % 64) / 2; }
__host__ __device__ __forceinline__ int perm32(int rho) { const int n = rho >> 4, i = rho & 15; return 8 * (i >> 2) + 4 * n + (i & 3); }

struct Unit { int pm, pn; };
struct Gemm { const bf16_t* A; const bf16_t* Bt; int M, N, K; };

struct StaticOrder {
    int nM, nN, nwg, G, c;
    __host__ __device__ void init(int M, int N, int G_, int c_) { nM = M / BM; nN = N / BM; nwg = nM * nN; G = G_; c = c_; }
    __host__ __device__ bool next(int i, Unit& u) const {
        const long L = (long)i * G + c; if (L >= nwg) return false;
        int wgid = (int)L; { const int q = nwg / NXCD, r = nwg % NXCD, xcd = wgid % NXCD, off = wgid / NXCD; wgid = (xcd < r ? xcd * (q + 1) : r * (q + 1) + (xcd - r) * q) + off; }
        const int nig = WGM * nN, gid = wgid / nig, fm = gid * WGM, gsz = (nM - fm) < WGM ? (nM - fm) : WGM;
        u.pm = fm + ((wgid % nig) % gsz); u.pn = (wgid % nig) / gsz; return true;
    }
    __device__ __forceinline__ void a_ready(const Unit&) const {}
    __device__ __forceinline__ void done(const Unit&) const {}
};

__device__ __forceinline__ unsigned cvt_pk_bf16(float lo, float hi) { unsigned r; asm volatile("v_cvt_pk_bf16_f32 %0, %1, %2" : "=v"(r) : "v"(lo), "v"(hi)); return r; }
typedef float f32x2 __attribute__((ext_vector_type(2)));
template <class Epi, class Sched, bool ALIGN_EPI = false, bool SP2 = false>
__device__ __forceinline__ void gemm_phase(PG8_LAS unsigned char* lds, const Gemm g, const Sched& S, const Epi& E) {
    int tid_ = threadIdx.x; asm volatile("" : "+v"(tid_));
    const int tid = tid_, wid = __builtin_amdgcn_readfirstlane(tid >> 6), lane = tid & 63, wr = wid >> 2, wc = wid & 3, fr = lane & 15, fq = lane >> 4;
    const int K = g.K, nt = K / BK;
    unsigned voffA[2], voffB[2];
#pragma unroll
    for (int i = 0; i < 2; ++i) { int R, C; stage_rc(tid * 16 + i * 8192, R, C); const int Rb = Epi::PERM ? ((R & ~31) + perm32(R & 31)) : R;
        voffA[i] = (unsigned)(R * K + C) * 2u; voffB[i] = (unsigned)(Rb * K + C) * 2u; }
    const size_t kstep = (size_t)(BK * 2);
    const size_t hstep = (size_t)HALF * K * 2;
    const size_t tstep = 2 * hstep;
    const unsigned ldsw = (unsigned)wid * 1024u;
    const int aoff = lds_byte(wr * 64 + fr, fq * 8), boff = lds_byte(wc * 32 + fr, fq * 8);
#define PG8_SA(b, h) (((b) * 2 + (h)) * HTB)
#define PG8_SB(b, h) ((4 + (b) * 2 + (h)) * HTB)
#define PG8_STAGE(bufoff, gbase, voff) do { _Pragma("unroll") for (int _i = 0; _i < 2; ++_i) \
        __builtin_amdgcn_global_load_lds((const unsigned*)((const char*)(gbase) + (voff)[_i]), (PG8_LAS unsigned*)(lds + (bufoff) + ldsw + _i * 8192), 16, 0, 0); } while (0)
#define PG8_LDA(dst, b, h) do { _Pragma("unroll") for (int m = 0; m < 4; ++m) _Pragma("unroll") for (int k = 0; k < 2; ++k) dst[m][k] = *(const PG8_LAS bf16x8*)(lds + PG8_SA(b, h) + aoff + m * 2048 + k * 1024); } while (0)
#define PG8_LDB(dst, b, h) do { _Pragma("unroll") for (int n = 0; n < 2; ++n) _Pragma("unroll") for (int k = 0; k < 2; ++k) dst[n][k] = *(const PG8_LAS bf16x8*)(lds + PG8_SB(b, h) + boff + n * 2048 + k * 1024); } while (0)
#define PG8_MMA(ai, bj, At, Bt) do { __builtin_amdgcn_s_setprio(1); _Pragma("unroll") for (int m = 0; m < 4; ++m) _Pragma("unroll") for (int n = 0; n < 2; ++n) _Pragma("unroll") for (int k = 0; k < 2; ++k) \
        acc[ai][bj][m][n] = __builtin_amdgcn_mfma_f32_16x16x32_bf16(Bt[n][k], At[m][k], acc[ai][bj][m][n], 0, 0, 0); __builtin_amdgcn_s_setprio(0); } while (0)
#define PG8_WAIT_V(n) asm volatile("s_waitcnt vmcnt(" #n ")" ::: "memory")
#define PG8_WAIT_L(n) asm volatile("s_waitcnt lgkmcnt(" #n ")" ::: "memory")
#define PG8_BAR __builtin_amdgcn_s_barrier()
#define PG8_SCHED __builtin_amdgcn_sched_barrier(0)
    Unit cur, nxt; int ui = 0;
    if (!S.next(0, cur)) return;
    f32x4 acc[2][2][4][2];
#pragma unroll
    for (int a = 0; a < 2; ++a)
#pragma unroll
        for (int b = 0; b < 2; ++b)
#pragma unroll
            for (int m = 0; m < 4; ++m)
#pragma unroll
                for (int n = 0; n < 2; ++n) acc[a][b][m][n] = (f32x4){0.f, 0.f, 0.f, 0.f};
    bf16x8 At[4][2], B0[2][2], B1[2][2];
    const char* cA = (const char*)g.A + (size_t)cur.pm * tstep; const char* cB = (const char*)g.Bt + (size_t)cur.pn * tstep;
    S.a_ready(cur);
    if constexpr (SP2) {
        PG8_STAGE(PG8_SB(0, 0), cB, voffB); PG8_STAGE(PG8_SB(0, 1), cB + hstep, voffB); PG8_STAGE(PG8_SA(0, 0), cA, voffA); PG8_STAGE(PG8_SA(0, 1), cA + hstep, voffA);
        if (wr == 1) PG8_BAR;
        PG8_WAIT_V(2); PG8_BAR;
        PG8_STAGE(PG8_SB(1, 0), cB + kstep, voffB); PG8_STAGE(PG8_SA(1, 0), cA + kstep, voffA); PG8_STAGE(PG8_SB(1, 1), cB + hstep + kstep, voffB);
        PG8_WAIT_V(6); PG8_BAR;
    } else {
        PG8_STAGE(PG8_SB(0, 0), cB, voffB); PG8_STAGE(PG8_SA(0, 0), cA, voffA); PG8_STAGE(PG8_SB(0, 1), cB + hstep, voffB); PG8_STAGE(PG8_SA(0, 1), cA + hstep, voffA);
        if (wr == 1) PG8_BAR;
        PG8_WAIT_V(4); PG8_BAR;
        PG8_STAGE(PG8_SB(1, 0), cB + kstep, voffB); PG8_STAGE(PG8_SA(1, 0), cA + kstep, voffA); PG8_STAGE(PG8_SB(1, 1), cB + hstep + kstep, voffB);
        PG8_WAIT_V(6); PG8_BAR;
    }
    for (;;) {
        const bool has_next = S.next(ui + 1, nxt);
        const char* nA = has_next ? (const char*)g.A + (size_t)nxt.pm * tstep : cA; const char* nB = has_next ? (const char*)g.Bt + (size_t)nxt.pn * tstep : cB;
        for (int t = 0; t < nt; t += 2) {
            const bool last = (t == nt - 2);
            const char* a1 = cA + (size_t)(t + 1) * kstep;
            const char* a2 = last ? nA : cA + (size_t)(t + 2) * kstep; const char* b2 = last ? nB : cB + (size_t)(t + 2) * kstep;
            const char* a3 = a2 + kstep; const char* b3 = b2 + kstep;
            if (last && has_next) S.a_ready(nxt);
            if constexpr (SP2) {
            PG8_LDB(B0, 0, 0); PG8_LDB(B1, 0, 1); PG8_SCHED; PG8_LDA(At, 0, 0); PG8_STAGE(PG8_SA(1, 1), a1 + hstep, voffA);
            PG8_WAIT_V(8); PG8_WAIT_L(0); PG8_BAR; PG8_MMA(0, 0, At, B0); PG8_MMA(0, 1, At, B1); PG8_BAR; PG8_SCHED;
            PG8_LDA(At, 0, 1); PG8_STAGE(PG8_SB(0, 0), b2, voffB); PG8_STAGE(PG8_SB(0, 1), b2 + hstep, voffB); PG8_STAGE(PG8_SA(0, 0), a2, voffA);
            PG8_WAIT_V(8); PG8_WAIT_L(0); PG8_BAR; PG8_MMA(1, 0, At, B0); PG8_MMA(1, 1, At, B1); PG8_BAR; PG8_SCHED;
            PG8_LDB(B0, 1, 0); PG8_LDB(B1, 1, 1); PG8_SCHED; PG8_LDA(At, 1, 0); PG8_STAGE(PG8_SA(0, 1), a2 + hstep, voffA);
            PG8_WAIT_V(8); PG8_WAIT_L(0); PG8_BAR; PG8_MMA(0, 0, At, B0); PG8_MMA(0, 1, At, B1); PG8_BAR; PG8_SCHED;
            PG8_LDA(At, 1, 1); PG8_STAGE(PG8_SB(1, 0), b3, voffB); PG8_STAGE(PG8_SB(1, 1), b3 + hstep, voffB); PG8_STAGE(PG8_SA(1, 0), a3, voffA);
            PG8_WAIT_V(8); PG8_WAIT_L(0); PG8_BAR; PG8_MMA(1, 0, At, B0); PG8_MMA(1, 1, At, B1); PG8_BAR; PG8_SCHED;
            } else {
            PG8_LDB(B0, 0, 0); PG8_SCHED; PG8_LDA(At, 0, 0); PG8_STAGE(PG8_SA(1, 1), a1 + hstep, voffA);
            PG8_WAIT_L(8); PG8_BAR; PG8_WAIT_L(0); PG8_MMA(0, 0, At, B0); PG8_BAR; PG8_SCHED;
            PG8_LDB(B1, 0, 1); PG8_STAGE(PG8_SB(0, 0), b2, voffB);
            PG8_BAR; PG8_WAIT_L(0); PG8_MMA(0, 1, At, B1); PG8_BAR;
            PG8_LDA(At, 0, 1); PG8_STAGE(PG8_SA(0, 0), a2, voffA);
            PG8_BAR; PG8_WAIT_L(0); PG8_MMA(1, 0, At, B0); PG8_BAR; PG8_SCHED;
            PG8_STAGE(PG8_SB(0, 1), b2 + hstep, voffB);
            PG8_WAIT_V(6); PG8_BAR; PG8_MMA(1, 1, At, B1); PG8_BAR;
            PG8_LDB(B0, 1, 0); PG8_SCHED; PG8_LDA(At, 1, 0); PG8_STAGE(PG8_SA(0, 1), a2 + hstep, voffA);
            PG8_WAIT_L(8); PG8_BAR; PG8_WAIT_L(0); PG8_MMA(0, 0, At, B0); PG8_BAR; PG8_SCHED;
            PG8_LDB(B1, 1, 1); PG8_STAGE(PG8_SB(1, 0), b3, voffB);
            PG8_BAR; PG8_WAIT_L(0); PG8_MMA(0, 1, At, B1); PG8_BAR;
            PG8_LDA(At, 1, 1); PG8_STAGE(PG8_SA(1, 0), a3, voffA);
            PG8_BAR; PG8_WAIT_L(0); PG8_MMA(1, 0, At, B0); PG8_BAR; PG8_SCHED;
            PG8_STAGE(PG8_SB(1, 1), b3 + hstep, voffB);
            PG8_WAIT_V(6); PG8_BAR; PG8_MMA(1, 1, At, B1); PG8_BAR;
            }
        }
        if constexpr (ALIGN_EPI) { if (wr == 0) PG8_BAR; }
        if constexpr (!Epi::AFTER_DRAIN) { E(acc, cur, wr, wc, fr, fq); S.done(cur); }
        if (!has_next) break;
#pragma unroll
        for (int a = 0; a < 2; ++a)
#pragma unroll
            for (int b = 0; b < 2; ++b)
#pragma unroll
                for (int m = 0; m < 4; ++m)
#pragma unroll
                    for (int n = 0; n < 2; ++n) acc[a][b][m][n] = (f32x4){0.f, 0.f, 0.f, 0.f};
        cur = nxt; cA = nA; cB = nB; ++ui;
        if constexpr (ALIGN_EPI) { if (wr == 1) PG8_BAR; }
    }
    PG8_WAIT_V(0);
    if constexpr (!ALIGN_EPI) { if (wr == 0) PG8_BAR; }
    PG8_BAR;
    if constexpr (Epi::AFTER_DRAIN) { E.fused(acc, cur, wr, wc, fr, fq, lds, wid, lane); S.done(cur); }
#undef PG8_SA
#undef PG8_SB
#undef PG8_STAGE
#undef PG8_LDA
#undef PG8_LDB
#undef PG8_MMA
#undef PG8_WAIT_V
#undef PG8_WAIT_L
#undef PG8_BAR
#undef PG8_SCHED
}
}

constexpr int D = 1024, BATCH = 16, SEQ = 4096, DEPTH = 4, MTOK = BATCH * SEQ;
constexpr int NH = 4, DV = 256, DQK = 128, INCOLS = 8200, N1 = 8192, DMIX = 2048, DCONV = 1024;
constexpr int CHUNK = 64, NCH = SEQ / CHUNK, NSEG = 4, CPS = NCH / NSEG;
constexpr int NUNIT = BATCH * NH * NSEG;
constexpr float EPS = 1e-6f;
constexpr int NWAVES = 8;

constexpr size_t MiB = 1u << 20;
constexpr size_t WS_CTL = 0, CTL_ZERO_BYTES = 65536;
constexpr size_t WS_BT1 = 2 * MiB;
constexpr size_t WS_BT2 = 66 * MiB;
constexpr size_t WS_WG = 82 * MiB;
constexpr size_t WS_RSTD = 83 * MiB;
constexpr size_t WS_LI = 84 * MiB;
constexpr size_t WS_LF = 85 * MiB;
constexpr size_t WS_FIX = 86 * MiB;
constexpr size_t FIX_ARR = 256 * 2 * 1024;
constexpr size_t WS_SEGC = 94 * MiB;
constexpr size_t WS_SEGN = 126 * MiB;
constexpr size_t WS_SEGS = 127 * MiB;
constexpr size_t WS_XB = 128 * MiB;
constexpr size_t WS_QKV = 256 * MiB;
constexpr size_t WS_MIX = 512 * MiB;
constexpr size_t WS_OUT = 768 * MiB;
constexpr size_t WS_END = 896 * MiB;
constexpr size_t WS_DBG = 896 * MiB;
constexpr int CW_BAR = 4096;

constexpr int RING_BYTES = 131072;
constexpr int EPI_OFF = RING_BYTES;
constexpr int CONVW_OFF = EPI_OFF + 8192;
constexpr int LDS_BYTES = 163840;
constexpr int MISC_OFF = LDS_BYTES - 512;

#define GAS __attribute__((address_space(1)))
#define LAS __attribute__((address_space(3)))
typedef unsigned short bf16;
typedef unsigned v4u __attribute__((ext_vector_type(4)));
typedef unsigned v2u __attribute__((ext_vector_type(2)));
typedef float f32x4 __attribute__((ext_vector_type(4)));
typedef short bf16x8 __attribute__((ext_vector_type(8)));
typedef short s16x4 __attribute__((ext_vector_type(4)));
#define LDS_WAIT() asm volatile("s_waitcnt lgkmcnt(0)" ::: "memory")
#define VM_WAIT() asm volatile("s_waitcnt vmcnt(0)" ::: "memory")
using pg8::cvt_pk_bf16;
__device__ __forceinline__ float bf_lo(unsigned u) { return __builtin_bit_cast(float, u << 16); }
__device__ __forceinline__ float bf_hi(unsigned u) { return __builtin_bit_cast(float, u & 0xffff0000u); }
__device__ __forceinline__ float dpp_ror1(float v) { return __int_as_float(__builtin_amdgcn_mov_dpp(__float_as_int(v), 0x121, 0xf, 0xf, true)); }
__device__ __forceinline__ float dpp_ror2(float v) { return __int_as_float(__builtin_amdgcn_mov_dpp(__float_as_int(v), 0x122, 0xf, 0xf, true)); }
__device__ __forceinline__ float dpp_shr1(float old, float v) { return __int_as_float(__builtin_amdgcn_update_dpp(__float_as_int(old), __float_as_int(v), 0x111, 0xf, 0xf, false)); }
__device__ __forceinline__ float dpp_shr2(float old, float v) { return __int_as_float(__builtin_amdgcn_update_dpp(__float_as_int(old), __float_as_int(v), 0x112, 0xf, 0xf, false)); }
__device__ __forceinline__ float sigmoidf_(float x) { return 1.0f / (1.0f + __expf(-x)); }
__device__ __forceinline__ float xadd16(float v) { const auto r = __builtin_amdgcn_permlane16_swap(__float_as_uint(v), __float_as_uint(v), false, false); return __uint_as_float(r[0]) + __uint_as_float(r[1]); }
__device__ __forceinline__ float xadd32(float v) { const auto r = __builtin_amdgcn_permlane32_swap(__float_as_uint(v), __float_as_uint(v), false, false); return __uint_as_float(r[0]) + __uint_as_float(r[1]); }
#define DPP_ADD0(v, ctrl) ((v) + __int_as_float(__builtin_amdgcn_update_dpp(0, __float_as_int(v), (ctrl), 0xf, 0xf, false)))
__device__ __forceinline__ float wave_sum(float v) {
    v = DPP_ADD0(v, 0xB1); v = DPP_ADD0(v, 0x4E); v = DPP_ADD0(v, 0x124); v = DPP_ADD0(v, 0x128);
    return xadd32(xadd16(v));
}

#define XB_TMO      128
#define XB_XCNT(j)  (256  + 64 * (j))
#define XB_XSUB(j)  (1280 + 64 * (j))
#define XB_XGEN(j)  (2304 + 64 * (j))
#define XB_TOP      3328
#define XB_TOPGEN   3392
#define XCD_BAR_WORDS 3456
#define XB_SPIN_CAP (1u << 18)
__device__ __forceinline__ unsigned xb_ld(unsigned* p)              { return __hip_atomic_load(p, __ATOMIC_RELAXED, __HIP_MEMORY_SCOPE_AGENT); }
__device__ __forceinline__ unsigned xb_add(unsigned* p, unsigned v) { return __hip_atomic_fetch_add(p, v, __ATOMIC_RELAXED, __HIP_MEMORY_SCOPE_AGENT); }
__device__ __forceinline__ unsigned xb_xcc_id() { return (unsigned)__builtin_amdgcn_s_getreg((3 << 11) | 20) & 0xFu; }
#define XB_SPIN(cond, bar) do { unsigned _sp = 0; while (cond) { __builtin_amdgcn_s_sleep(1); \
    if ((++_sp & 255u) == 0u) { if (xb_ld(&(bar)[XB_TMO])) break; if (_sp > XB_SPIN_CAP) { atomicAdd(&(bar)[XB_TMO], 1u); break; } } } } while (0)
struct XcdBarrier { unsigned* bar; unsigned x; volatile LAS unsigned* st; };
__device__ __forceinline__ XcdBarrier xcd_barrier_post(unsigned* bar, volatile LAS unsigned* st) {
    XcdBarrier b; b.bar = bar; b.x = xb_xcc_id(); b.st = st;
    if (threadIdx.x == 0) (void)xb_add(&bar[XB_XCNT(b.x)], 1u);
    return b;
}
__device__ __forceinline__ void xcd_barrier_complete(unsigned* bar, unsigned x, unsigned& nloc, unsigned& nx) {
    const unsigned G = gridDim.x * gridDim.y * gridDim.z;
    unsigned sum, cnt, mine, sp = 0u;
    for (;;) {
        sum = 0u; cnt = 0u; mine = 0u;
#pragma unroll
        for (unsigned j = 0; j < 16; ++j) { const unsigned c = xb_ld(&bar[XB_XCNT(j)]); sum += c; cnt += (c > 0u) ? 1u : 0u; mine = (j == x) ? c : mine; }
        if (sum == G) break;
        __builtin_amdgcn_s_sleep(1);
        if ((++sp & 255u) == 0u) { if (xb_ld(&bar[XB_TMO])) break; if (sp > XB_SPIN_CAP) { atomicAdd(&bar[XB_TMO], 1u); break; } }
    }
    nloc = mine > 0u ? mine : 1u; nx = cnt > 0u ? cnt : 1u;
}
__device__ __forceinline__ void xcd_barrier(const XcdBarrier& b) {
    asm volatile("s_waitcnt vmcnt(0)" ::: "memory");
    __syncthreads();
    if (threadIdx.x == 0) {
        unsigned* bar = b.bar; const unsigned bx = xb_xcc_id();
        __builtin_amdgcn_s_waitcnt(0);
        unsigned nloc = b.st[0], nx = b.st[1];
        if (nloc == 0u) { xcd_barrier_complete(bar, bx, nloc, nx); b.st[0] = nloc; b.st[1] = nx; }
        const unsigned old = xb_add(&bar[XB_XSUB(bx)], 1u);
        const unsigned gen = old / nloc;
        if (old + 1u == (gen + 1u) * nloc) {
            __builtin_amdgcn_fence(__ATOMIC_RELEASE, "agent");
            asm volatile("s_waitcnt vmcnt(0)" ::: "memory");
            const unsigned og = xb_add(&bar[XB_TOP], 1u);
            const unsigned tg = og / nx;
            if (og + 1u == (tg + 1u) * nx) xb_add(&bar[XB_TOPGEN], 1u);
            else XB_SPIN(xb_ld(&bar[XB_TOPGEN]) == tg, bar);
            __builtin_amdgcn_fence(__ATOMIC_ACQUIRE, "agent");
            xb_add(&bar[XB_XGEN(bx)], 1u);
            asm volatile("s_waitcnt vmcnt(0)" ::: "memory");
        } else {
            XB_SPIN(xb_ld(&bar[XB_XGEN(bx)]) == gen, bar);
            __builtin_amdgcn_fence(__ATOMIC_ACQUIRE, "agent");
            asm volatile("s_waitcnt vmcnt(0)" ::: "memory");
        }
    }
    __syncthreads();
}

struct Frame {
    LAS unsigned char* lds;
    int tid, lane, wave, vcu, G;
    const float *x, *norm_pre, *norm_post, *w_in, *b_i, *b_f, *head_norm, *conv_w, *conv_norm, *w_out;
    float* out;
    unsigned char* ws;
};

__host__ __device__ __forceinline__ int rho_plain(int ci) {
    const int wc = ci >> 6, bj = (ci >> 5) & 1, fq = (ci >> 3) & 3, n = (ci >> 2) & 1, e = ci & 3;
    return 128 * bj + 32 * wc + 16 * n + 4 * fq + e;
}
__host__ __device__ __forceinline__ int dest1(int cc) {
    if (cc < 2048) return (cc & ~255) + rho_plain(cc & 255);
    if (cc < 4096) { const int qn = (cc - 2048) >> 10, ch = cc & 1023, gt = ch >> 7, c = ch & 127;
        const int wc = c >> 5, fq = (c >> 3) & 3, bj = (c >> 2) & 1, e = c & 3;
        return 256 * (8 + gt) + 128 * bj + 32 * wc + 16 * qn + 4 * fq + e; }
    { const int qn = (cc - 4096) >> 10, ch = cc & 1023, g = ch >> 6, c = ch & 63;
      const int wc = c >> 4, fq = ((c >> 3) & 1) | (((c >> 2) & 1) << 1), e = c & 3, bj = qn >> 1, n = qn & 1;
      return 256 * (16 + g) + 128 * bj + 32 * wc + 16 * n + 4 * fq + e; }
}

struct PrepItem { const float* W; const float* gk; bf16* WT; int ldw, k0, src, cc0, Kd, which; float cscale; };
__device__ __forceinline__ PrepItem prep_item(const Frame& F, int it) {
    constexpr int I1 = 16 * 256, I2 = 32 * 32;
    const int l = it / (I1 + I2); int r = it % (I1 + I2); PrepItem p;
    if (r < I1) { const int kb = r >> 8, cb = r & 255, cc0 = cb * 32;
        p.W = F.w_in + (size_t)l * D * INCOLS; p.ldw = INCOLS; p.k0 = kb * 64; p.src = cc0 < 4096 ? cc0 : cc0 + 8; p.cc0 = cc0; p.gk = F.norm_pre + l * D; p.cscale = cc0 < 512 ? 0.08838834764831845f : ((cc0 >= 2048 && cc0 < 4096) || cc0 >= 7168) ? -1.4426950408889634f : 1.0f;
        p.WT = (bf16*)(F.ws + WS_BT1) + (size_t)l * N1 * D; p.Kd = D; p.which = 0;
    } else { r -= I1; const int kb = r >> 5, cb = r & 31;
        p.W = F.w_out + (size_t)l * DMIX * D; p.ldw = D; p.k0 = kb * 64; p.src = cb * 32; p.cc0 = cb * 32; p.gk = F.norm_pre; p.cscale = 1.0f;
        p.WT = (bf16*)(F.ws + WS_BT2) + (size_t)l * D * DMIX; p.Kd = DMIX; p.which = 1; }
    return p;
}
__device__ __forceinline__ void prep_load(const PrepItem& p, f32x4 (&ld)[8], int lane) {
#pragma unroll
    for (int i = 0; i < 8; ++i) ld[i] = *(const GAS f32x4*)(p.W + (size_t)(p.k0 + 8 * i + (lane >> 3)) * p.ldw + p.src + 4 * (lane & 7));
}
__device__ __forceinline__ void prep_finish(const PrepItem& p, const f32x4 (&ld)[8], LAS float* scr, int lane) {
#pragma unroll
    for (int i = 0; i < 8; ++i) { const int kk = 8 * i + (lane >> 3); f32x4 v = ld[i];
        if (p.which == 0) v = v * (p.gk[p.k0 + kk] * p.cscale);
        LAS float* d = scr + kk * 33 + 4 * (lane & 7); d[0] = v.x; d[1] = v.y; d[2] = v.z; d[3] = v.w; }
    LDS_WAIT(); asm volatile("" ::: "memory");
    const int c = lane & 7;
#pragma unroll
    for (int j = 0; j < 4; ++j) { const int n = (lane >> 3) + 8 * j; const LAS float* s = scr + (8 * c) * 33 + n;
        v4u o; o.x = cvt_pk_bf16(s[0 * 33], s[1 * 33]); o.y = cvt_pk_bf16(s[2 * 33], s[3 * 33]); o.z = cvt_pk_bf16(s[4 * 33], s[5 * 33]); o.w = cvt_pk_bf16(s[6 * 33], s[7 * 33]);
        const int cc = p.cc0 + n; const int row = (p.which == 0) ? dest1(cc) : ((cc & ~255) + rho_plain(cc & 255));
        *(GAS v4u*)(p.WT + (size_t)row * p.Kd + p.k0 + 8 * c) = o; }
    LDS_WAIT(); asm volatile("" ::: "memory");
}
__device__ __forceinline__ void prep_phase(Frame& F) {
    LAS float* scr = (LAS float*)(F.lds + F.wave * 16384);
    const int gw = F.vcu * NWAVES + F.wave, NGW = F.G * NWAVES;
    constexpr int NIT = DEPTH * (16 * 256 + 32 * 32);
    f32x4 la[8], lb[8], lc[8]; PrepItem pa, pb, pc;
    int it = gw;
#define PREP_LOAD(p, r, idx) do { if ((idx) < NIT) { p = prep_item(F, (idx)); prep_load(p, r, F.lane); } } while (0)
    PREP_LOAD(pa, la, it); PREP_LOAD(pb, lb, it + NGW); PREP_LOAD(pc, lc, it + 2 * NGW);
    for (; it < NIT; it += 3 * NGW) {
        prep_finish(pa, la, scr, F.lane); PREP_LOAD(pa, la, it + 3 * NGW);
        if (it + NGW < NIT) { prep_finish(pb, lb, scr, F.lane); PREP_LOAD(pb, lb, it + 4 * NGW); }
        if (it + 2 * NGW < NIT) { prep_finish(pc, lc, scr, F.lane); PREP_LOAD(pc, lc, it + 5 * NGW); }
    }
#undef PREP_LOAD
    float* wg = (float*)(F.ws + WS_WG);
    for (int i = (F.vcu * NWAVES + F.wave) * 64 + F.lane; i < DEPTH * 8 * D; i += F.G * NWAVES * 64) {
        const int l = i / (8 * D), j = (i / D) & 7, k = i % D;
        wg[i] = F.w_in[(size_t)l * D * INCOLS + (size_t)k * INCOLS + 4096 + j] * F.norm_pre[l * D + k];
    }
}

#define DPP_ADD(v, ctrl) ((v) + __int_as_float(__builtin_amdgcn_update_dpp(0, __float_as_int(v), (ctrl), 0xf, 0xf, false)))
__device__ __forceinline__ float row_sum16(float v) { v = DPP_ADD(v, 0xB1); v = DPP_ADD(v, 0x4E); v = DPP_ADD(v, 0x124); v = DPP_ADD(v, 0x128); return v; }
__device__ __forceinline__ float wave_sum2(float v) { v = row_sum16(v); v = xadd32(xadd16(v)); return v; }
typedef __bf16 bf16x2_t __attribute__((ext_vector_type(2)));
__device__ __forceinline__ float dot2bf(unsigned a, unsigned b, float acc) { return __builtin_amdgcn_fdot2_f32_bf16(__builtin_bit_cast(bf16x2_t, a), __builtin_bit_cast(bf16x2_t, b), acc, false); }
__device__ __forceinline__ float dpp_x1(float v) { return __int_as_float(__builtin_amdgcn_update_dpp(0, __float_as_int(v), 0xB1, 0xf, 0xf, false)); }
__device__ __forceinline__ float dpp_x2(float v) { return __int_as_float(__builtin_amdgcn_update_dpp(0, __float_as_int(v), 0x4E, 0xf, 0xf, false)); }
constexpr int TNR = 2;
struct ThinCtx { const float* x; bf16* XB; const bf16* OUTB; float* out; float* RSTD; float* LI; float* LF; LAS float* wgl; int l, lane; bool wn; float bi, bfv; };
__device__ __forceinline__ void thin_load(const ThinCtx& c, v4u (&raw)[TNR][4], float (&rsd)[TNR], const size_t m0, const size_t mstep) {
#pragma unroll
    for (int r = 0; r < TNR; ++r) { const size_t m = m0 + (size_t)r * mstep;
        rsd[r] = 1.0f;
        if (c.l == 0) {
#pragma unroll
            for (int q = 0; q < 4; ++q) raw[r][q] = *(const GAS v4u*)(c.x + m * D + 256 * q + 4 * c.lane);
        } else {
            rsd[r] = c.RSTD[m];
#pragma unroll
            for (int q = 0; q < 4; ++q) { const v2u a = *(const GAS v2u*)(c.XB + m * D + 256 * q + 4 * c.lane), b = *(const GAS v2u*)(c.OUTB + m * D + 256 * q + 4 * c.lane);
                raw[r][q] = (v4u){a.x, a.y, b.x, b.y}; }
        } }
}
__device__ __forceinline__ void thin_rows(const ThinCtx& c, const v4u (&raw)[TNR][4], const float (&rsd)[TNR], const f32x4 (&gp)[4], const v4u (&wreg)[8][2], const size_t m0, const size_t mstep) {
    const int lane = c.lane;
#pragma unroll
    for (int r = 0; r < TNR; ++r) { const size_t m = m0 + (size_t)r * mstep;
        f32x4 v[4];
        if (c.l == 0) {
#pragma unroll
            for (int q = 0; q < 4; ++q) v[q] = __builtin_bit_cast(f32x4, raw[r][q]);
        } else {
            f32x4 o[4]; float ss = 0.f;
            const float unr = __builtin_amdgcn_rcpf(rsd[r]);
#pragma unroll
            for (int q = 0; q < 4; ++q) { const v4u w = raw[r][q]; v[q] = (f32x4){bf_lo(w.x), bf_hi(w.x), bf_lo(w.y), bf_hi(w.y)} * unr;
                o[q] = (f32x4){bf_lo(w.z), bf_hi(w.z), bf_lo(w.w), bf_hi(w.w)}; ss += (o[q].x * o[q].x + o[q].y * o[q].y) + (o[q].z * o[q].z + o[q].w * o[q].w); }
            const float rs = __builtin_amdgcn_rsqf(wave_sum2(ss) * (1.0f / D) + EPS);
#pragma unroll
            for (int q = 0; q < 4; ++q) { v[q] = v[q] + o[q] * rs * gp[q]; if (!c.wn) *(GAS f32x4*)(c.out + m * D + 256 * q + 4 * lane) = v[q]; }
        }
        if (c.wn) {
            float ss = 0.f;
#pragma unroll
            for (int q = 0; q < 4; ++q) ss += (v[q].x * v[q].x + v[q].y * v[q].y) + (v[q].z * v[q].z + v[q].w * v[q].w);
            ss = row_sum16(ss); ss = xadd32(xadd16(ss));
            const float rstd = __builtin_amdgcn_rsqf(ss * (1.0f / D) + EPS);
            unsigned xw[8];
#pragma unroll
            for (int q = 0; q < 4; ++q) { const f32x4 vn = v[q] * rstd; xw[2 * q] = cvt_pk_bf16(vn.x, vn.y); xw[2 * q + 1] = cvt_pk_bf16(vn.z, vn.w);
                *(GAS v2u*)(c.XB + m * D + 256 * q + 4 * lane) = (v2u){xw[2 * q], xw[2 * q + 1]}; }
            if (lane == 0) c.RSTD[m] = rstd;
            float a[8];
#pragma unroll
            for (int j = 0; j < 8; ++j) { const v4u w0 = wreg[j][0], w1 = wreg[j][1];
                float s = 0.f;
                s = dot2bf(xw[0], w0.x, s); s = dot2bf(xw[1], w0.y, s); s = dot2bf(xw[2], w0.z, s); s = dot2bf(xw[3], w0.w, s);
                s = dot2bf(xw[4], w1.x, s); s = dot2bf(xw[5], w1.y, s); s = dot2bf(xw[6], w1.z, s); s = dot2bf(xw[7], w1.w, s);
                a[j] = s; }
            const bool o1 = lane & 1, o2 = lane & 2;
            float b4[4];
#pragma unroll
            for (int i = 0; i < 4; ++i) { const float keep = o1 ? a[2 * i + 1] : a[2 * i], send = o1 ? a[2 * i] : a[2 * i + 1]; b4[i] = keep + dpp_x1(send); }
            float c2[2];
#pragma unroll
            for (int i = 0; i < 2; ++i) { const float keep = o2 ? b4[2 * i + 1] : b4[2 * i], send = o2 ? b4[2 * i] : b4[2 * i + 1]; c2[i] = keep + dpp_x2(send); }
#pragma unroll
            for (int i = 0; i < 2; ++i) { c2[i] = DPP_ADD(c2[i], 0x124); c2[i] = DPP_ADD(c2[i], 0x128); c2[i] = xadd32(xadd16(c2[i])); }
            if (lane < 4) { const int b = (int)(m >> 12), t = (int)(m & (SEQ - 1));
                const float xi = c2[0] + c.bi, xf = c2[1] + c.bfv;
                c.LI[(size_t)(b * NH + lane) * SEQ + t] = xi;
                c.LF[(size_t)(b * NH + lane) * SEQ + t] = fminf(xf, 0.f) - __logf(1.0f + __expf(-fabsf(xf))); }
        }
    }
}
__device__ __forceinline__ void thin_phase(Frame& F, const int l, const bool wn) {
    const int gw = F.vcu * NWAVES + F.wave, NGW = F.G * NWAVES, lane = F.lane;
    ThinCtx c; c.x = F.x; c.XB = (bf16*)(F.ws + WS_XB); c.OUTB = (const bf16*)(F.ws + WS_OUT); c.out = F.out; c.RSTD = (float*)(F.ws + WS_RSTD);
    c.LI = (float*)(F.ws + WS_LI); c.LF = (float*)(F.ws + WS_LF); c.wgl = (LAS float*)F.lds; c.l = l; c.lane = lane; c.wn = wn; c.bi = 0.f; c.bfv = 0.f;
    if (wn) {
        const float* wgp = (const float*)(F.ws + WS_WG) + (size_t)l * 8 * D;
#pragma unroll
        for (int i = 0; i < 4; ++i) { const int idx = F.tid + 512 * i, j = idx >> 8, k4 = idx & 255, q = k4 >> 6, ln = k4 & 63;
            f32x4 wv;
            if (l == 0) { const float* wc0 = F.w_in + (size_t)(4 * k4) * INCOLS + 4096 + j; const f32x4 gpre = *(const GAS f32x4*)(F.norm_pre + 4 * k4);
                wv = (f32x4){wc0[0] * gpre.x, wc0[INCOLS] * gpre.y, wc0[2 * INCOLS] * gpre.z, wc0[3 * INCOLS] * gpre.w}; }
            else wv = *(const GAS f32x4*)(wgp + j * D + 4 * k4);
            v2u pk; pk.x = cvt_pk_bf16(wv.x, wv.y); pk.y = cvt_pk_bf16(wv.z, wv.w);
            *(LAS v2u*)((LAS unsigned*)c.wgl + (j * 64 + ln) * 8 + 2 * q) = pk; }
        c.bi = F.b_i[l * NH + (lane & 3)]; c.bfv = F.b_f[l * NH + (lane & 3)];
    }
    __syncthreads();
    v4u wreg[8][2];
#pragma unroll
    for (int j = 0; j < 8; ++j) { wreg[j][0] = (v4u){0u, 0u, 0u, 0u}; wreg[j][1] = wreg[j][0]; }
    if (wn) {
#pragma unroll
        for (int j = 0; j < 8; ++j) { wreg[j][0] = *(const LAS v4u*)((LAS unsigned*)c.wgl + (j * 64 + lane) * 8); wreg[j][1] = *(const LAS v4u*)((LAS unsigned*)c.wgl + (j * 64 + lane) * 8 + 4); }
    }
    f32x4 gp[4];
#pragma unroll
    for (int q = 0; q < 4; ++q) gp[q] = (f32x4){0.f, 0.f, 0.f, 0.f};
    if (l > 0) {
#pragma unroll
        for (int q = 0; q < 4; ++q) gp[q] = *(const GAS f32x4*)(F.norm_post + (l - 1) * D + 256 * q + 4 * lane);
    }
    const size_t step = (size_t)NGW, trip = TNR * (size_t)NGW;
    v4u ra[TNR][4], rb[TNR][4]; float sa[TNR], sb[TNR];
    size_t m0 = (size_t)gw;
    thin_load(c, ra, sa, m0, step);
    for (; m0 < (size_t)MTOK; m0 += 2 * trip) {
        if (m0 + trip < (size_t)MTOK) thin_load(c, rb, sb, m0 + trip, step);
        thin_rows(c, ra, sa, gp, wreg, m0, step);
        if (m0 + trip < (size_t)MTOK) {
            if (m0 + 2 * trip < (size_t)MTOK) thin_load(c, ra, sa, m0 + 2 * trip, step);
            thin_rows(c, rb, sb, gp, wreg, m0 + trip, step);
        }
    }
    __syncthreads();
}

__device__ __forceinline__ unsigned dppx1u(unsigned v) { return (unsigned)__builtin_amdgcn_update_dpp(0, (int)v, 0xB1, 0xf, 0xf, false); }
template <bool SKIPPABLE>
__device__ __forceinline__ void store_plain_tile(const pg8::f32x4 (&acc)[2][2][4][2], bf16* base, size_t ld, int row0, int col0, int fr, int fq, bool skip) {
    const bool odd = fr & 1;
#pragma unroll
    for (int ai = 0; ai < 2; ++ai)
#pragma unroll
        for (int m = 0; m < 4; ++m) {
            v4u a[2];
#pragma unroll
            for (int bj = 0; bj < 2; ++bj) { const f32x4 v0 = acc[ai][bj][m][0], v1 = acc[ai][bj][m][1];
                a[bj].x = cvt_pk_bf16(v0[0], v0[1]); a[bj].y = cvt_pk_bf16(v0[2], v0[3]); a[bj].z = cvt_pk_bf16(v1[0], v1[1]); a[bj].w = cvt_pk_bf16(v1[2], v1[3]); }
            const v4u snd = odd ? a[0] : a[1];
            v4u rcv; rcv.x = dppx1u(snd.x); rcv.y = dppx1u(snd.y); rcv.z = dppx1u(snd.z); rcv.w = dppx1u(snd.w);
            const int r = row0 + ai * 128 + m * 16;
            bf16* pe = base + (size_t)(r & ~1) * ld + col0 + (odd ? 32 : 0) + 8 * fq;
            bf16* po = base + (size_t)(r | 1) * ld + col0 + (odd ? 32 : 0) + 8 * fq;
            const v4u de = odd ? rcv : a[0], dq = odd ? a[1] : rcv;
            if (!SKIPPABLE || !skip) { *(GAS v4u*)pe = de; *(GAS v4u*)po = dq; }
        }
}
#ifdef PROBE
#define EPI_ST(stmt) { if (!skipst) { stmt } }
#else
#define EPI_ST(stmt) { stmt }
#endif
#ifdef USE_NT
#define NT_ST(p, v) __builtin_nontemporal_store((v), (p))
#else
#define NT_ST(p, v) (*(p) = (v))
#endif
struct Epi1 {
    static constexpr bool PERM = false, AFTER_DRAIN = false;
    bf16* QKV; bf16* MIX; const float* RSTD; const LAS float* cwl; float* fix; LAS unsigned char* elds; bf16* DBGG; int mode; bool skipst;
    __device__ __forceinline__ void operator()(pg8::f32x4 (&acc)[2][2][4][2], const pg8::Unit& u, int wr, int wc, int fr, int fq) const {
        asm volatile("" : "+v"(fr), "+v"(fq));
        const int row0 = u.pm * 256 + wr * 64 + fr;
#ifdef PROBE
        if (mode == 3) {
            f32x4 s = (f32x4){0.f, 0.f, 0.f, 0.f};
#pragma unroll
            for (int ai = 0; ai < 2; ++ai)
#pragma unroll
                for (int bj = 0; bj < 2; ++bj)
#pragma unroll
                    for (int mm = 0; mm < 4; ++mm) s += acc[ai][bj][mm][0] + acc[ai][bj][mm][1];
            EPI_ST(*(GAS f32x4*)(fix + 4 * FIX_ARR + (size_t)(wr * 4 + wc) * 256 + (fq * 16 + fr) * 4) = s;)
            return; }
        if (mode == 2 || u.pn < 8) {
#else
        if (u.pn < 8) {
#endif
#ifdef PROBE
            store_plain_tile<true>(acc, QKV, 2048, row0, (u.pn & 7) * 256 + 64 * wc, fr, fq, skipst);
#else
            store_plain_tile<false>(acc, QKV, 2048, row0, (u.pn & 7) * 256 + 64 * wc, fr, fq, false);
#endif
        } else if (u.pn < 16) {
#pragma unroll
            for (int ai = 0; ai < 2; ++ai)
#pragma unroll
                for (int m = 0; m < 4; ++m) { const int r = row0 + ai * 128 + m * 16;
                    f32x4 g[2];
#pragma unroll
                    for (int bj = 0; bj < 2; ++bj) { const f32x4 os = acc[ai][bj][m][0], zs = acc[ai][bj][m][1]; f32x4 a, b, r;
#pragma unroll
                        for (int e = 0; e < 4; ++e) { a[e] = __builtin_amdgcn_exp2f(zs[e]); b[e] = __builtin_amdgcn_exp2f(os[e]); }
                        const f32x4 d = (a * -1.4426950408889634f + -1.4426950408889634f) * (b + 1.0f);
#pragma unroll
                        for (int e = 0; e < 4; ++e) r[e] = __builtin_amdgcn_rcpf(d[e]);
                        g[bj] = zs * r; }
                    v4u w; w.x = cvt_pk_bf16(g[0][0], g[0][1]); w.y = cvt_pk_bf16(g[0][2], g[0][3]); w.z = cvt_pk_bf16(g[1][0], g[1][1]); w.w = cvt_pk_bf16(g[1][2], g[1][3]);
                    EPI_ST(NT_ST((v4u*)(MIX + (size_t)r * 2048 + (u.pn - 8) * 128 + 32 * wc + 8 * fq), w);)
#ifdef DBG
                    EPI_ST(*(GAS v4u*)(DBGG + (size_t)r * 1024 + (u.pn - 8) * 128 + 32 * wc + 8 * fq) = w;)
#endif
                    }
        } else {
            const int g = u.pn - 16, ch0 = 64 * g + 16 * wc + 8 * (fq & 1) + 4 * (fq >> 1);
            LAS float* halo = (LAS float*)elds;
            LAS float* part = (LAS float*)(elds + 2048);
            float* cuL = fix; float* cuF = fix + FIX_ARR; float* bF = fix + 2 * FIX_ARR; float* zF = fix + 3 * FIX_ARR;
#pragma unroll
            for (int ai = 0; ai < 2; ++ai)
#pragma unroll
                for (int m = 0; m < 4; ++m) acc[ai][0][m][0] = acc[ai][0][m][0] * acc[ai][1][m][0];
#pragma unroll
            for (int ai = 0; ai < 2; ++ai) {
                if (fr >= 14) { *(LAS f32x4*)(halo + ((2 * ai + wr) * 2 + (fr - 14)) * 64 + 16 * wc + 4 * fq) = acc[ai][0][3][0];
                    if (ai == 1 && wr == 1) EPI_ST(*(GAS f32x4*)(cuL + ((size_t)u.pm * 2 + (fr - 14)) * 1024 + ch0) = acc[1][0][3][0];) }
            }
            if (wr == 0 && fr < 2) { const size_t o = ((size_t)u.pm * 2 + fr) * 1024 + ch0;
                EPI_ST(*(GAS f32x4*)(cuF + o) = acc[0][0][0][0];) EPI_ST(*(GAS f32x4*)(bF + o) = acc[0][0][0][1];) EPI_ST(*(GAS f32x4*)(zF + o) = acc[0][1][0][1];) }
            LDS_WAIT(); __builtin_amdgcn_s_barrier(); asm volatile("" ::: "memory");
            const f32x4 w0 = *(const LAS f32x4*)(cwl + ch0), w1 = *(const LAS f32x4*)(cwl + 1024 + ch0), w2 = *(const LAS f32x4*)(cwl + 2048 + ch0);
#pragma unroll
            for (int ai = 0; ai < 2; ++ai) {
                const int blk = 2 * ai + wr;
                f32x4 p1 = (f32x4){0.f, 0.f, 0.f, 0.f}, p2 = p1;
                if (blk > 0) { p1 = *(const LAS f32x4*)(halo + ((blk - 1) * 2 + 1) * 64 + 16 * wc + 4 * fq); p2 = *(const LAS f32x4*)(halo + ((blk - 1) * 2 + (fr & 1)) * 64 + 16 * wc + 4 * fq); }
#pragma unroll
                for (int m = 0; m < 4; ++m) {
                    const f32x4 cu = acc[ai][0][m][0]; f32x4 s1, s2, a1, a2;
#pragma unroll
                    for (int e = 0; e < 4; ++e) { a1[e] = dpp_shr1(p1[e], cu[e]); a2[e] = dpp_shr2(p2[e], cu[e]);
                        if (m < 3) { s1[e] = dpp_ror1(cu[e]); s2[e] = dpp_ror2(cu[e]); } else { s1[e] = 0.f; s2[e] = 0.f; } }
                    const f32x4 cv = w2 * cu + w1 * a1 + w0 * a2;
                    const f32x4 bc = acc[ai][0][m][1] * cv;
                    acc[ai][1][m][0] = bc;
                    float ss = (bc[0] * bc[0] + bc[1] * bc[1]) + (bc[2] * bc[2] + bc[3] * bc[3]);
                    ss = xadd32(xadd16(ss));
                    if (fq == 0) part[(128 * ai + 64 * wr + 16 * m + fr) * 4 + wc] = ss;
                    p1 = s1; p2 = s2;
                }
            }
            LDS_WAIT(); __builtin_amdgcn_s_barrier(); asm volatile("" ::: "memory");
            const f32x4 gc = *(const LAS f32x4*)(cwl + 3072 + ch0);
#pragma unroll
            for (int ai = 0; ai < 2; ++ai)
#pragma unroll
                for (int mp = 0; mp < 2; ++mp) {
                    v2u wq[2];
#pragma unroll
                    for (int mo = 0; mo < 2; ++mo) { const int m = 2 * mp + mo, rt = 128 * ai + 64 * wr + 16 * m + fr;
                        const f32x4 ps = *(const LAS f32x4*)(part + rt * 4);
                        const float rg = __builtin_amdgcn_rsqf(((ps[0] + ps[1]) + (ps[2] + ps[3])) * (1.0f / 64.0f) + EPS);
                        const f32x4 zs = acc[ai][1][m][1], bc = acc[ai][1][m][0]; f32x4 a, r;
#pragma unroll
                        for (int e = 0; e < 4; ++e) a[e] = __builtin_amdgcn_exp2f(zs[e]);
                        a = a + 1.0f;
#pragma unroll
                        for (int e = 0; e < 4; ++e) r[e] = __builtin_amdgcn_rcpf(a[e]);
                        const f32x4 y = (zs * r) * (bc * (gc * rg));
                        wq[mo].x = cvt_pk_bf16(y[0], y[1]); wq[mo].y = cvt_pk_bf16(y[2], y[3]); }
                    const auto sx = __builtin_amdgcn_permlane32_swap(wq[0].x, wq[1].x, false, false), sy = __builtin_amdgcn_permlane32_swap(wq[0].y, wq[1].y, false, false);
                    v4u w; w.x = sx[0]; w.y = sy[0]; w.z = sx[1]; w.w = sy[1];
                    const int rt = 128 * ai + 64 * wr + 16 * (2 * mp + (fq >> 1)) + fr;
                    EPI_ST(*(GAS v4u*)(MIX + (size_t)(u.pm * 256 + rt) * 2048 + 1024 + 64 * g + 16 * wc + 8 * (fq & 1)) = w;) }
        }
    }
};
#ifndef DYN_ROUNDS
#define DYN_ROUNDS 2
#endif
constexpr size_t CTL_TICKET = 57344;
struct Order1 {
    pg8::StaticOrder sc, sg, sq, sall; int rc, rg; bool sweeps;
    unsigned* tick; volatile LAS unsigned* tl; int dyn0;
    __device__ void init(int G_, int c_) { sc.init(MTOK, 4096, G_, c_); sg.init(MTOK, 2048, G_, c_); sq.init(MTOK, 2048, G_, c_); sall.init(MTOK, N1, G_, c_);
        rc = sc.nwg / G_; rg = sg.nwg / G_; sweeps = (sc.nwg % G_ == 0) && (sg.nwg % G_ == 0); }
    __device__ bool next(int i, pg8::Unit& u) const {
        if (!sweeps) return sall.next(i, u);
        if (i < rc) { sc.next(i, u); u.pn += 16; return true; }
#ifdef ORDER_QKV_BEFORE_GATE
        if (i < rc + rg) { sq.next(i - rc, u); return true; }
        if (i < rc + 2 * rg) { sg.next(i - rc - rg, u); u.pn += 8; return true; }
#else
        if (i < rc + rg) { sg.next(i - rc, u); u.pn += 8; return true; }
        if (i < dyn0) { sq.next(i - rc - rg, u); return true; }
#endif
        {
            if (threadIdx.x < 64) { unsigned t = 0u; if (threadIdx.x == 0) t = __hip_atomic_fetch_add(tick, 1u, __ATOMIC_RELAXED, __HIP_MEMORY_SCOPE_AGENT);
                t = (unsigned)__builtin_amdgcn_readfirstlane((int)t); if (threadIdx.x == 0) tl[0] = t; }
            asm volatile("s_waitcnt lgkmcnt(0)" ::: "memory"); __builtin_amdgcn_s_barrier(); asm volatile("" ::: "memory");
            const unsigned t = tl[0];
            if (t >= (unsigned)(DYN_ROUNDS * sq.G)) return false;
            pg8::StaticOrder o = sq; o.c = (int)(t % (unsigned)sq.G); o.next(dyn0 - rc - rg + (int)(t / (unsigned)sq.G), u); return true; }
    }
    __device__ __forceinline__ void a_ready(const pg8::Unit&) const {}
    __device__ __forceinline__ void done(const pg8::Unit&) const {}
};
struct Epi2 {
    static constexpr bool PERM = false, AFTER_DRAIN = false;
    bf16* O;
    __device__ __forceinline__ void operator()(pg8::f32x4 (&acc)[2][2][4][2], const pg8::Unit& u, int wr, int wc, int fr, int fq) const {
        const int row0 = u.pm * 256 + wr * 64 + fr;
        store_plain_tile<false>(acc, O, 1024, row0, u.pn * 256 + 64 * wc, fr, fq, false);
    }
};

__device__ __forceinline__ void conv_fixup(Frame& F, const int l, const int gw, const int NGW) {
    const float* fix = (const float*)(F.ws + WS_FIX);
    const float *cuL = fix, *cuF = fix + FIX_ARR, *bF = fix + 2 * FIX_ARR, *zF = fix + 3 * FIX_ARR;
    const float* cw = F.conv_w + (size_t)l * 3 * DCONV; const float* cg = F.conv_norm + (size_t)l * DCONV;
    bf16* MIX = (bf16*)(F.ws + WS_MIX);
    const int lane = F.lane;
    for (int it0 = gw; it0 < 256 * 2 * 16; it0 += 4 * NGW) {
        float c0[4], c1[4], pl0[4], pl1[4], bb[4], zz[4], w0[4], w1[4], w2[4], gg[4];
#pragma unroll
        for (int k = 0; k < 4; ++k) { const int it = it0 + k * NGW, pm = (it >> 5) & 255, rr = (it >> 4) & 1, g = it & 15, ch = 64 * g + lane, pmp = pm > 0 ? pm - 1 : 0;
            c0[k] = cuF[((size_t)pm * 2 + 0) * 1024 + ch]; c1[k] = cuF[((size_t)pm * 2 + 1) * 1024 + ch];
            pl0[k] = cuL[((size_t)pmp * 2 + 0) * 1024 + ch]; pl1[k] = cuL[((size_t)pmp * 2 + 1) * 1024 + ch];
            bb[k] = bF[((size_t)pm * 2 + rr) * 1024 + ch]; zz[k] = zF[((size_t)pm * 2 + rr) * 1024 + ch];
            w0[k] = cw[ch]; w1[k] = cw[1024 + ch]; w2[k] = cw[2048 + ch]; gg[k] = cg[ch]; }
#pragma unroll
        for (int k = 0; k < 4; ++k) { const int it = it0 + k * NGW, pm = it >> 5, rr = (it >> 4) & 1, g = it & 15, ch = 64 * g + lane;
            if (it >= 256 * 2 * 16 || (pm & 15) == 0) continue;
            const float cv = rr == 0 ? (w2[k] * c0[k] + w1[k] * pl1[k] + w0[k] * pl0[k]) : (w2[k] * c1[k] + w1[k] * c0[k] + w0[k] * pl1[k]);
            const float bc = bb[k] * cv;
            const float rg = rsqrtf(wave_sum(bc * bc) * (1.0f / 64.0f) + EPS);
            const float z = zz[k] * -0.6931471805599453f;
            const float y = z * sigmoidf_(z) * bc * rg * gg[k];
            MIX[(size_t)(pm * 256 + rr) * 2048 + 1024 + ch] = (bf16)(cvt_pk_bf16(y, y) & 0xffffu); }
    }
}

namespace ml {
#ifndef MC_ABL
#define MC_ABL 0
#endif
template <bool PASSC> struct Lay;
template <> struct Lay<true>  { static constexpr int NBUF = 2, BUFB = 65536, Q = 0, K = 16384, V = 32768, SC = 139264, SW = 3072, SM = 4096; };
template <> struct Lay<false> { static constexpr int NBUF = 3, BUFB = 49152, Q = 0, K = 0, V = 16384, SC = 147456, SW = 0, SM = 1024; };
constexpr int L_P = 131072;
constexpr int SP = 0, SMM = 1024, SB = 2048;
constexpr int RSP = 0, QN = 128, HN = 192, NV = 704, DEC = 832, MST = 848, BLS = 868, CML = 884;
static_assert(Lay<true>::SC + (Lay<true>::SM + 900) * 4 <= MISC_OFF && Lay<false>::SC + (Lay<false>::SM + 900) * 4 <= MISC_OFF && Lay<false>::NBUF * Lay<false>::BUFB <= Lay<false>::SC, "mLSTM LDS map");
__device__ __forceinline__ unsigned swz(unsigned row) { return ((row & 3) << 2) | ((row >> 2) & 3); }
__device__ __forceinline__ unsigned off_b(unsigned row, unsigned ch) { return 256u * row + 16u * (ch ^ swz(row)); }
__device__ __forceinline__ unsigned tr_addr16(unsigned lane, unsigned c, unsigned ks, unsigned t) {
    const unsigned g = lane >> 4, q = (lane & 15) >> 2, p = lane & 3;
    return off_b(32 * ks + 8 * g + 4 * t + q, 2 * c + (p >> 1)) + 8 * (p & 1);
}
__device__ __forceinline__ unsigned tr_addr16v(unsigned lane, unsigned c, unsigned ks, unsigned t) {
    const unsigned g = lane >> 4, q = (lane & 15) >> 2, p0 = lane & 3, p = ((p0 & 1) << 1) | (p0 >> 1);
    return off_b(32 * ks + 8 * g + 4 * t + q, 2 * c + (p >> 1)) + 8 * (p & 1);
}
__device__ __forceinline__ void tr_read8(s16x4 (&o)[8], const unsigned (&a)[8]) {
    asm volatile("ds_read_b64_tr_b16 %0, %8\n\tds_read_b64_tr_b16 %1, %9\n\tds_read_b64_tr_b16 %2, %10\n\tds_read_b64_tr_b16 %3, %11\n\t"
                 "ds_read_b64_tr_b16 %4, %12\n\tds_read_b64_tr_b16 %5, %13\n\tds_read_b64_tr_b16 %6, %14\n\tds_read_b64_tr_b16 %7, %15\n\ts_waitcnt lgkmcnt(0)"
                 : "=&v"(o[0]), "=&v"(o[1]), "=&v"(o[2]), "=&v"(o[3]), "=&v"(o[4]), "=&v"(o[5]), "=&v"(o[6]), "=&v"(o[7])
                 : "v"(a[0]), "v"(a[1]), "v"(a[2]), "v"(a[3]), "v"(a[4]), "v"(a[5]), "v"(a[6]), "v"(a[7]) : "memory");
}
template <int O0, int O1, int O2, int O3, int O4, int O5, int O6, int O7>
__device__ __forceinline__ void tr_read8o(s16x4 (&o)[8], unsigned a0, unsigned a1, unsigned a2, unsigned a3, unsigned a4, unsigned a5, unsigned a6, unsigned a7) {
    asm volatile("ds_read_b64_tr_b16 %0, %8 offset:%16\n\tds_read_b64_tr_b16 %1, %9 offset:%17\n\tds_read_b64_tr_b16 %2, %10 offset:%18\n\tds_read_b64_tr_b16 %3, %11 offset:%19\n\t"
                 "ds_read_b64_tr_b16 %4, %12 offset:%20\n\tds_read_b64_tr_b16 %5, %13 offset:%21\n\tds_read_b64_tr_b16 %6, %14 offset:%22\n\tds_read_b64_tr_b16 %7, %15 offset:%23\n\ts_waitcnt lgkmcnt(0)"
                 : "=&v"(o[0]), "=&v"(o[1]), "=&v"(o[2]), "=&v"(o[3]), "=&v"(o[4]), "=&v"(o[5]), "=&v"(o[6]), "=&v"(o[7])
                 : "v"(a0), "v"(a1), "v"(a2), "v"(a3), "v"(a4), "v"(a5), "v"(a6), "v"(a7), "i"(O0), "i"(O1), "i"(O2), "i"(O3), "i"(O4), "i"(O5), "i"(O6), "i"(O7) : "memory");
}
__device__ __forceinline__ unsigned lds_u32(const LAS unsigned char* p) { return (unsigned)(unsigned long)p; }
__device__ __forceinline__ bf16x8 cat8(s16x4 a, s16x4 b) { return (bf16x8){a[0], a[1], a[2], a[3], b[0], b[1], b[2], b[3]}; }
__device__ __forceinline__ bf16x8 pack8(const f32x4 a, const f32x4 b) {
    const unsigned x = cvt_pk_bf16(a[0], a[1]), y = cvt_pk_bf16(a[2], a[3]), z = cvt_pk_bf16(b[0], b[1]), w = cvt_pk_bf16(b[2], b[3]);
    return __builtin_bit_cast(bf16x8, (v4u){x, y, z, w});
}
__device__ __forceinline__ bf16x8 scale8(const bf16x8 v, const f32x4 s0, const f32x4 s1) {
    const v4u u = __builtin_bit_cast(v4u, v);
    const unsigned x = cvt_pk_bf16(bf_lo(u.x) * s0[0], bf_hi(u.x) * s0[1]), y = cvt_pk_bf16(bf_lo(u.y) * s0[2], bf_hi(u.y) * s0[3]);
    const unsigned z = cvt_pk_bf16(bf_lo(u.z) * s1[0], bf_hi(u.z) * s1[1]), w = cvt_pk_bf16(bf_lo(u.w) * s1[2], bf_hi(u.w) * s1[3]);
    return __builtin_bit_cast(bf16x8, (v4u){x, y, z, w});
}
__device__ __forceinline__ float dot8(const bf16x8 v, const f32x4 s0, const f32x4 s1) {
    const v4u u = __builtin_bit_cast(v4u, v);
    return (bf_lo(u.x) * s0[0] + bf_hi(u.x) * s0[1]) + (bf_lo(u.y) * s0[2] + bf_hi(u.y) * s0[3]) + (bf_lo(u.z) * s1[0] + bf_hi(u.z) * s1[1]) + (bf_lo(u.w) * s1[2] + bf_hi(u.w) * s1[3]);
}
#define MFMA16(a, b, c) __builtin_amdgcn_mfma_f32_16x16x32_bf16(a, b, c, 0, 0, 0)
#define GLDS16(src, dst) __builtin_amdgcn_global_load_lds((const unsigned*)(src), (LAS unsigned*)(dst), 16, 0, 0)
#define GLDS16NT(src, dst) __builtin_amdgcn_global_load_lds((const unsigned*)(src), (LAS unsigned*)(dst), 16, 0, 2)

template <bool PASSC>
__device__ __forceinline__ void dma_chunk(LAS unsigned char* lds, int buf, const bf16* QKV, size_t rowbase, int h, int w, int lane) {
    typedef Lay<PASSC> L;
    const int rr = lane >> 4, pos = lane & 15;
#pragma unroll
    for (int i = 0; i < 2; ++i) { const int r0 = 4 * (2 * w + i), row = r0 + rr; const unsigned sch = pos ^ swz(row);
        const bf16* src = QKV + (rowbase + row) * 2048 + h * 128 + 8 * sch;
        if (PASSC) GLDS16(src, lds + buf * L::BUFB + L::Q + 256 * r0);
        GLDS16(src + 512, lds + buf * L::BUFB + L::K + 256 * r0); }
#pragma unroll
    for (int i = 0; i < 4; ++i) { const int pc = 4 * w + i, img = pc >> 4, r0 = 4 * (pc & 15), row = r0 + rr; const unsigned sch = pos ^ swz(row);
        GLDS16(QKV + (rowbase + row) * 2048 + 1024 + h * 256 + img * 128 + 8 * sch, lds + buf * L::BUFB + L::V + img * 16384 + 256 * r0); }
}

template <bool PASSC>
__device__ __forceinline__ void dma_chunk2(LAS unsigned char* lds, int buf, const bf16* QKV, size_t rowbase, int h, int w, unsigned dq0, unsigned dv0) {
    typedef Lay<PASSC> L;
    const unsigned char* qb = (const unsigned char*)(QKV + rowbase * 2048 + h * 128);
    const unsigned char* vb = qb + h * 256;
#pragma unroll
    for (int i = 0; i < 2; ++i) { const int r0 = 4 * (2 * w + i); const unsigned o = i == 0 ? dq0 : (dq0 ^ 16u) + 16384u;
        if (PASSC) { GLDS16NT(qb + o, lds + buf * L::BUFB + L::Q + 256 * r0); GLDS16NT(qb + o + 1024, lds + buf * L::BUFB + L::K + 256 * r0); }
        else GLDS16(qb + o + 1024, lds + buf * L::BUFB + L::K + 256 * r0); }
#pragma unroll
    for (int i = 0; i < 4; ++i) { const int pc = 4 * w + i, img = pc >> 4, r0 = 4 * (pc & 15); const unsigned o = (dv0 ^ (unsigned)(16 * i)) + 16384u * i;
        if (PASSC) GLDS16NT(vb + o, lds + buf * L::BUFB + L::V + img * 16384 + 256 * r0); else GLDS16(vb + o, lds + buf * L::BUFB + L::V + img * 16384 + 256 * r0); }
}

template <bool PASSC>
__device__ __forceinline__ void unit(Frame& F, const int l, const int un, const int abl = 0) {
    typedef Lay<PASSC> L;
    LAS unsigned char* lds = F.lds; LAS float* sc = (LAS float*)(lds + L::SC); LAS float* sm = sc + L::SM;
    int tid0 = F.tid; asm volatile("" : "+v"(tid0)); const int w = F.wave;
    const int seg = un & (NSEG - 1), bh = un >> 2, b = bh >> 2, h = bh & 3;
    const bf16* QKV = (const bf16*)(F.ws + WS_QKV); bf16* MIX = (bf16*)(F.ws + WS_MIX); bf16* MIXO = abl ? (bf16*)(F.ws + WS_OUT) - 1024 * 0 : MIX;
    const float* LF = (const float*)(F.ws + WS_LF); const float* LI = (const float*)(F.ws + WS_LI);
    float* SEGC = (float*)(F.ws + WS_SEGC); float* SEGN = (float*)(F.ws + WS_SEGN); float* SEGS = (float*)(F.ws + WS_SEGS);
    const size_t row00 = (size_t)b * SEQ + (size_t)seg * CPS * CHUNK;
    const size_t g00 = (size_t)bh * SEQ + (size_t)seg * CPS * CHUNK;

    int tid = tid0, lane = tid0 & 63, fr = lane & 15, fq = lane >> 4;
#ifdef PROBE
#define USTAMP(i) do { if (PASSC && l == 1 && blockIdx.x == PROBE_BLK && threadIdx.x == 0) ((volatile LAS unsigned long long*)(F.lds + MISC_OFF + 64))[30 + (i)] = wall_clock64(); } while (0)
#else
#define USTAMP(i) do {} while (0)
#endif
    USTAMP(0);
    __syncthreads();
    dma_chunk<PASSC>(lds, 0, QKV, row00, h, w, lane);
    if (!PASSC) dma_chunk<PASSC>(lds, 1, QKV, row00 + CHUNK, h, w, lane);
    f32x4 C[8][2];
#pragma unroll
    for (int dt = 0; dt < 8; ++dt) { C[dt][0] = (f32x4){0.f, 0.f, 0.f, 0.f}; C[dt][1] = C[dt][0]; }
    float nreg = 0.f, m = PASSC ? 0.f : -1e30f;
    if (PASSC) {
        v4u cw[NSEG - 1][8]; float sbj[NSEG - 1], mlj[NSEG - 1], nj[NSEG - 1];
#pragma unroll
        for (int j = 0; j < NSEG - 1; ++j) if (j < seg) {
            const int uj = bh * NSEG + j; sbj[j] = SEGS[uj * 4 + 0]; mlj[j] = SEGS[uj * 4 + 1]; nj[j] = SEGN[uj * 128 + 16 * w + fr];
            const unsigned* cp = (const unsigned*)SEGC + (size_t)uj * 16384 + (size_t)w * 2048 + lane * 4;
#pragma unroll
            for (int dt = 0; dt < 8; ++dt) cw[j][dt] = *(const GAS v4u*)(cp + dt * 256); }
#pragma unroll
        for (int j = 0; j < NSEG - 1; ++j) if (j < seg) {
            const float mn = fmaxf(m + sbj[j], mlj[j]), fa = __expf(m + sbj[j] - mn), fb = __expf(mlj[j] - mn);
#pragma unroll
            for (int dt = 0; dt < 8; ++dt) { const v4u q = cw[j][dt];
                const f32x4 c0 = (f32x4){bf_lo(q.x), bf_hi(q.x), bf_lo(q.y), bf_hi(q.y)}, c1 = (f32x4){bf_lo(q.z), bf_hi(q.z), bf_lo(q.w), bf_hi(q.w)};
                C[dt][0] = C[dt][0] * fa + c0 * fb; C[dt][1] = C[dt][1] * fa + c1 * fb; }
            nreg = nreg * fa + nj[j] * fb;
            m = mn; }
        if (fq == 0) sm[NV + 16 * w + fr] = nreg;
    }
    float pj[2], cmj[2], bLj[2];
#pragma unroll
    for (int j = 0; j < 2; ++j) { const int c = 2 * w + j; const float lf = LF[g00 + c * CHUNK + lane], li = LI[g00 + c * CHUNK + lane];
        float bb = lf;
#pragma unroll
        for (int o = 1; o < 64; o <<= 1) { const float t = __shfl_up(bb, o); if (lane >= o) bb += t; }
        const float p = li - bb; float cm = p;
#pragma unroll
        for (int o = 1; o < 64; o <<= 1) { const float t = __shfl_up(cm, o); if (lane >= o) cm = fmaxf(cm, t); }
        pj[j] = p; cmj[j] = cm; bLj[j] = __shfl(bb, 63);
        if (PASSC) { sc[SP + c * 64 + lane] = p; sc[SB + c * 64 + lane] = bb; }
        if (lane == 63) { sm[BLS + c] = bb; sm[CML + c] = cm; } }
    __syncthreads();
    float sum_bL = 0.f;
    if (w == 0) {
        float mm_ = m;
        for (int c = 0; c < CPS; ++c) { const float bL = sm[BLS + c], cmL = sm[CML + c], mn = fmaxf(bL + mm_, bL + cmL);
            if (lane == 0) { sm[MST + c] = mm_; sm[DEC + c] = PASSC ? __expf(bL + mm_ - mn) : sum_bL + bL; }
            mm_ = mn; sum_bL += bL; }
        if (lane == 0) sm[MST + CPS] = mm_;
        m = mm_;
    }
    __syncthreads();
#pragma unroll
    for (int j = 0; j < 2; ++j) { const int c = 2 * w + j; const float m0 = sm[MST + c], m1 = sm[MST + c + 1];
        if (PASSC) sc[SMM + c * 64 + lane] = fmaxf(m0, cmj[j]);
        sc[L::SW + c * 64 + lane] = PASSC ? __expf(bLj[j] + pj[j] - m1) : __expf(bLj[j] + pj[j] + (sm[DEC + CPS - 1] - sm[DEC + c]) - sm[MST + CPS]); }
    f32x4 gh[2];
    const int gq = ((fq & 1) << 1) | (fq >> 1);
    if (PASSC) { gh[0] = *(const GAS f32x4*)(F.head_norm + l * D + h * 256 + 32 * w + 4 * gq); gh[1] = *(const GAS f32x4*)(F.head_norm + l * D + h * 256 + 32 * w + 16 + 4 * gq); }

    v4u graw[4];
    if (PASSC) {
#pragma unroll
        for (int tt = 0; tt < 4; ++tt) graw[tt] = *(const GAS v4u*)(MIX + (row00 + 16 * tt + fr) * 2048 + h * 256 + 32 * w + 16 * (fq >> 1) + 8 * (fq & 1));
    }
    unsigned kt0, vt0, lpS, spw, qn0, bi0, bpr, fr4, goff, dq0, dv0;
    { const unsigned l0 = (unsigned)tid0 & 63u, fr0 = l0 & 15u, fq0 = l0 >> 4, f_ = fr0 & 3u, x_ = fr0 >> 2, g1_ = fq0 >> 1, h1_ = fq0 & 1u, y_ = fr0 >> 1;
      lpS = 256u * fr0 + 64u * f_ + 16u * (fq0 ^ x_);
      bi0 = 256u * fr0 + 64u * f_ + 16u * (g1_ ^ x_) + 8u * h1_;
      spw = L_P + 128u * (16u * (unsigned)(w >> 1) + fr0) + 8u * h1_ + 16u * ((4u * (unsigned)(w & 1) + g1_) ^ y_);
      bpr = L_P + 128u * fr0 + 64u * (y_ >> 2) + 16u * (fq0 ^ (y_ & 3u));
      { const unsigned t1 = (unsigned)tid0 >> 3, part = (unsigned)tid0 & 7u; qn0 = 256u * t1 + 16u * ((2u * part) ^ swz(t1)); }
      fr4 = 4u * fr0;
      goff = 4096u * fr0 + 32u * g1_ + 16u * h1_;
      { const unsigned rr = l0 >> 4, pos = l0 & 15u;
        dq0 = (8u * (unsigned)w + rr) * 4096u + 16u * (pos ^ (rr << 2) ^ ((2u * (unsigned)w) & 3u));
        dv0 = (4u * ((4u * (unsigned)w) & 15u) + rr) * 4096u + 2048u + (unsigned)(w >> 2) * 256u + 16u * (pos ^ (rr << 2)); } }
    { const unsigned l0 = (unsigned)tid0 & 63u, g_ = l0 >> 4, q_ = (l0 & 15u) >> 2, p_ = l0 & 3u, Lx = (q_ << 1) | (g_ & 1u), pv = ((p_ & 1u) << 1) | (p_ >> 1);
      kt0 = lds_u32(lds) + L::K + 256u * (8u * g_ + q_) + 32u * Lx + 16u * (p_ >> 1) + 8u * (p_ & 1u);
      vt0 = lds_u32(lds) + L::V + (unsigned)(w >> 2) * 16384u + 256u * (8u * g_ + q_) + 32u * ((2u * (unsigned)(w & 3)) ^ Lx) + 16u * (pv >> 1) + 8u * (pv & 1u); }
    USTAMP(1);
    for (int c = 0; c < CPS; ++c) {
        asm volatile("" : "+v"(kt0), "+v"(vt0), "+v"(lpS), "+v"(spw), "+v"(qn0), "+v"(bi0), "+v"(bpr), "+v"(fr4), "+v"(goff), "+v"(dq0), "+v"(dv0));
        if (c == 8) USTAMP(2);
        { int t_ = tid0; asm volatile("" : "+v"(t_)); tid = t_; lane = t_ & 63; fr = lane & 15; fq = lane >> 4; }
        const size_t rowb = row00 + (size_t)c * CHUNK;
        const unsigned bufo = (unsigned)(PASSC ? (c & 1) : (c % 3)) * (unsigned)L::BUFB;
        const LAS unsigned char* sccb = (const LAS unsigned char*)(sc + c * 64) + fr4;
        const LAS unsigned char* smb = (const LAS unsigned char*)sm + fr4;
        LAS float* scc = sc + c * 64;
        if (PASSC) { if (c == 0) asm volatile("s_waitcnt vmcnt(0) lgkmcnt(0)" ::: "memory");
                     else asm volatile("s_waitcnt vmcnt(8) lgkmcnt(0)" ::: "memory"); }
        else if (c + 1 >= CPS) asm volatile("s_waitcnt vmcnt(0) lgkmcnt(0)" ::: "memory");
        else asm volatile("s_waitcnt vmcnt(6) lgkmcnt(0)" ::: "memory");
        __builtin_amdgcn_s_barrier();
        asm volatile("" ::: "memory");
        if (c == 8) USTAMP(4);
        if (c == 9) USTAMP(7);
        f32x4 Y[4][2];
        if (PASSC) { if (c + 1 < CPS && !(abl & 128)) dma_chunk2<PASSC>(lds, (c + 1) & 1, QKV, rowb + CHUNK, h, w, dq0, dv0); }
        else { if (c + 2 < CPS) dma_chunk2<PASSC>(lds, (c + 2) % 3, QKV, rowb + 2 * CHUNK, h, w, dq0, dv0); }
        const float mc0 = sm[MST + c];
        if (PASSC) {
            if (!(abl & 16)) { const int ti = w >> 1, sh = w & 1, t = 16 * ti + fr; const float rt = -*(const LAS float*)(sccb + 4 * (SMM + 16 * ti));
              bf16x8 ka[2][4], qb[4];
              const unsigned sqa = lpS + (bufo + (unsigned)(L::Q + 4096 * ti)), ska = lpS + (bufo + (unsigned)(L::K + 8192 * sh));
#pragma unroll
              for (int ks = 0; ks < 4; ++ks) { qb[ks] = *(const LAS bf16x8*)(lds + (sqa ^ (unsigned)(64 * ks)));
                  ka[0][ks] = *(const LAS bf16x8*)(lds + (ska ^ (unsigned)(64 * ks))); ka[1][ks] = *(const LAS bf16x8*)(lds + (ska ^ (unsigned)(64 * ks)) + 4096); }
              float rsum = 0.f;
#pragma unroll
              for (int s2 = 0; s2 < 2; ++s2) { const int si = 2 * sh + s2; f32x4 a = (f32x4){0.f, 0.f, 0.f, 0.f};
#pragma unroll
                  for (int ks = 0; ks < 4; ++ks) a = MFMA16(ka[s2][ks], qb[ks], a);
                  const f32x4 ps = *(const LAS f32x4*)(scc + SP + 16 * si + 4 * fq); f32x4 pv;
#pragma unroll
                  for (int e = 0; e < 4; ++e) { const int s = 16 * si + 4 * fq + e; pv[e] = (s <= t) ? a[e] * __expf(rt + ps[e]) : 0.f; }
                  rsum += (pv[0] + pv[1]) + (pv[2] + pv[3]);
                  v2u pk; pk.x = cvt_pk_bf16(pv[0], pv[1]); pk.y = cvt_pk_bf16(pv[2], pv[3]);
                  *(LAS v2u*)(lds + (spw ^ (unsigned)(32 * s2))) = pk; }
              rsum = xadd32(xadd16(rsum));
              if (fq == 0) *(LAS float*)((LAS unsigned char*)sm + fr4 + 4 * (RSP + sh * 64 + 16 * ti)) = rsum; }
            if (!(abl & 16)) { const int t = tid >> 3, part = tid & 7; float a = 0.f;
#pragma unroll
              for (int hh = 0; hh < 2; ++hh) { const v4u qv = *(const LAS v4u*)(lds + ((qn0 + (bufo + (unsigned)L::Q)) ^ (unsigned)(16 * hh)));
                  const f32x4 n0 = *(const LAS f32x4*)(sm + NV + 16 * part + 8 * hh), n1 = *(const LAS f32x4*)(sm + NV + 16 * part + 8 * hh + 4);
                  a += bf_lo(qv.x) * n0[0] + bf_hi(qv.x) * n0[1] + bf_lo(qv.y) * n0[2] + bf_hi(qv.y) * n0[3] + bf_lo(qv.z) * n1[0] + bf_hi(qv.z) * n1[1] + bf_lo(qv.w) * n1[2] + bf_hi(qv.w) * n1[3]; }
              a = DPP_ADD0(a, 0xB1); a = DPP_ADD0(a, 0x4E); a = DPP_ADD0(a, 0x104);
              if (part == 0) sm[QN + t] = a; }
#pragma unroll
            for (int tt = 0; tt < 4; ++tt) { Y[tt][0] = (f32x4){0.f, 0.f, 0.f, 0.f}; Y[tt][1] = Y[tt][0]; }
            if (!(abl & 64))
#pragma unroll
            for (int ks = 0; ks < 4; ++ks) { const bf16x8 cf0 = pack8(C[2 * ks][0], C[2 * ks + 1][0]), cf1 = pack8(C[2 * ks][1], C[2 * ks + 1][1]);
                bf16x8 qp[4];
                const unsigned qa0 = (bi0 + (bufo + (unsigned)L::Q)) ^ (unsigned)(64 * ks), qa1 = qa0 ^ 32u;
#pragma unroll
                for (int tt = 0; tt < 4; ++tt) {
                    const v2u q0 = *(const LAS v2u*)(lds + qa0 + 4096 * tt), q1 = *(const LAS v2u*)(lds + qa1 + 4096 * tt);
                    qp[tt] = __builtin_bit_cast(bf16x8, (v4u){q0.x, q0.y, q1.x, q1.y}); }
#pragma unroll
                for (int tt = 0; tt < 4; ++tt) { if (!(abl & 32)) { const f32x4 z4 = (f32x4){0.f, 0.f, 0.f, 0.f};
                        Y[tt][0] = MFMA16(cf0, qp[tt], (ks == 0 && !abl) ? z4 : Y[tt][0]); Y[tt][1] = MFMA16(cf1, qp[tt], (ks == 0 && !abl) ? z4 : Y[tt][1]); } else { Y[tt][0] += __builtin_bit_cast(f32x4, qp[tt]); } } }
        }
        const unsigned vimg = L::V + (w >> 2) * 16384, vc0 = 2 * (w & 3);
        bf16x8 VT[2][2];
        { s16x4 o[8]; const unsigned vb = vt0 + (unsigned)(PASSC ? (c & 1) : (c % 3)) * (unsigned)L::BUFB, vb16 = vb ^ 16u, vb32 = vb ^ 32u, vb48 = vb ^ 48u;
          tr_read8o<0, 1024, 8192, 9216, 0, 1024, 8192, 9216>(o, vb, vb16, vb, vb16, vb32, vb48, vb32, vb48);
#pragma unroll
          for (int vt = 0; vt < 2; ++vt)
#pragma unroll
              for (int ks = 0; ks < 2; ++ks) VT[vt][ks] = cat8(o[4 * vt + 2 * ks], o[4 * vt + 2 * ks + 1]); }
        if (PASSC) {
            LDS_WAIT(); if (!(abl & 8)) __builtin_amdgcn_s_barrier(); asm volatile("" ::: "memory");
            if (c == 8) USTAMP(5);
            bf16x8 pb[4][2];
#pragma unroll
            for (int tt = 0; tt < 4; ++tt)
#pragma unroll
                for (int ks = 0; ks < 2; ++ks) pb[tt][ks] = *(const LAS bf16x8*)(lds + (bpr ^ (unsigned)(64 * ks)) + 2048 * tt);
            float mm4[4], sb4[4], r04[4], r14[4], qn4[4];
#pragma unroll
            for (int tt = 0; tt < 4; ++tt) { mm4[tt] = *(const LAS float*)(sccb + 4 * (SMM + 16 * tt)); sb4[tt] = *(const LAS float*)(sccb + 4 * (SB + 16 * tt));
                r04[tt] = *(const LAS float*)(smb + 4 * (RSP + 16 * tt)); r14[tt] = *(const LAS float*)(smb + 4 * (RSP + 64 + 16 * tt)); qn4[tt] = *(const LAS float*)(smb + 4 * (QN + 16 * tt)); }
#pragma unroll
            for (int tt = 0; tt < 4; ++tt) { const int t = 16 * tt + fr; const float mmv = mm4[tt], iw = __expf(mc0 - mmv);
                Y[tt][0] = Y[tt][0] * iw; Y[tt][1] = Y[tt][1] * iw;
#pragma unroll
                for (int ks = 0; ks < 2; ++ks) { Y[tt][0] = MFMA16(VT[0][ks], pb[tt][ks], Y[tt][0]); Y[tt][1] = MFMA16(VT[1][ks], pb[tt][ks], Y[tt][1]); }
                const float den = r04[tt] + r14[tt] + iw * qn4[tt];
                const float hs = __builtin_amdgcn_rcpf(fmaxf(fabsf(den), __expf(-(sb4[tt] + mmv))));
                Y[tt][0] = Y[tt][0] * hs; Y[tt][1] = Y[tt][1] * hs;
                float ss = 0.f;
#pragma unroll
                for (int e = 0; e < 4; ++e) ss += Y[tt][0][e] * Y[tt][0][e] + Y[tt][1][e] * Y[tt][1][e];
                ss = xadd32(xadd16(ss));
                if (fq == 0) *(LAS float*)((LAS unsigned char*)sm + 8 * fr4 + 4 * (HN + 128 * tt + w)) = ss; }
            LDS_WAIT(); if (!(abl & 8)) __builtin_amdgcn_s_barrier(); asm volatile("" ::: "memory");
            if (c == 8) USTAMP(6);
            f32x4 hp[4][2];
#pragma unroll
            for (int tt = 0; tt < 4; ++tt) { const LAS unsigned char* hb = (const LAS unsigned char*)sm + 8 * fr4 + 4 * (HN + 128 * tt); hp[tt][0] = *(const LAS f32x4*)hb; hp[tt][1] = *(const LAS f32x4*)(hb + 16); }
#pragma unroll
            for (int tt = 0; tt < 4; ++tt) { const int t = 16 * tt + fr;
                const f32x4 hs4 = hp[tt][0] + hp[tt][1]; const float tot = (hs4[0] + hs4[1]) + (hs4[2] + hs4[3]);
                const float rn = __builtin_amdgcn_rsqf(tot * (1.0f / 256.0f) + EPS);
                const auto g0 = __builtin_amdgcn_permlane32_swap(graw[tt].x, graw[tt].z, false, false), g1 = __builtin_amdgcn_permlane32_swap(graw[tt].y, graw[tt].w, false, false);
                const f32x4 y0 = Y[tt][0] * rn * gh[0], y1 = Y[tt][1] * rn * gh[1];
                const unsigned o0x = cvt_pk_bf16(y0[0] * bf_lo(g0[0]), y0[1] * bf_hi(g0[0])), o0y = cvt_pk_bf16(y0[2] * bf_lo(g1[0]), y0[3] * bf_hi(g1[0]));
                const unsigned o1x = cvt_pk_bf16(y1[0] * bf_lo(g0[1]), y1[1] * bf_hi(g0[1])), o1y = cvt_pk_bf16(y1[2] * bf_lo(g1[1]), y1[3] * bf_hi(g1[1]));
                const auto sx = __builtin_amdgcn_permlane32_swap(o0x, o1x, false, false), sy = __builtin_amdgcn_permlane32_swap(o0y, o1y, false, false);
                v4u ov; ov.x = sx[0]; ov.y = sy[0]; ov.z = sx[1]; ov.w = sy[1];
                if (!abl) *(GAS v4u*)((unsigned char*)(MIX + rowb * 2048 + h * 256 + 32 * w) + (goff + 65536u * tt)) = ov;
                else if (!(abl & 2) || (ov.x == 0x12345678u)) *(GAS v4u*)(MIXO + ((rowb + t) * 2048 + h * 256 + 32 * w + 16 * (fq >> 1) + 8 * (fq & 1)) % (size_t)(64u << 20)) = ov; }
            if (c + 1 < CPS && !(abl & 2)) {
#pragma unroll
                for (int tt = 0; tt < 4; ++tt) graw[tt] = *(const GAS v4u*)((const unsigned char*)(MIX + (rowb + CHUNK) * 2048 + h * 256 + 32 * w) + (goff + 65536u * tt));
            }
        }
        if (!(abl & 256)) { const float decay = sm[DEC + c]; float nsum = 0.f;
#pragma unroll
          for (int dt = 0; dt < 8; ++dt) if (PASSC) { C[dt][0] = C[dt][0] * decay; C[dt][1] = C[dt][1] * decay; }
#pragma unroll
          for (int ks = 0; ks < 2; ++ks) {
              const f32x4 w0 = *(const LAS f32x4*)(scc + L::SW + 32 * ks + 8 * fq), w1 = *(const LAS f32x4*)(scc + L::SW + 32 * ks + 8 * fq + 4);
              const bf16x8 vw0 = scale8(VT[0][ks], w0, w1), vw1 = scale8(VT[1][ks], w0, w1);
              bf16x8 kt[8];
              { const unsigned kb = kt0 + (unsigned)(PASSC ? (c & 1) : (c % 3)) * (unsigned)L::BUFB;
#pragma unroll
                for (int hf = 0; hf < 2; ++hf) { s16x4 o[8];
                    const unsigned a0 = kb ^ (unsigned)(128 * hf), a1 = a0 ^ 32u, a2 = a0 ^ 64u, a3 = a0 ^ 96u;
                    if (ks == 0) tr_read8o<0, 1024, 0, 1024, 0, 1024, 0, 1024>(o, a0, a0 ^ 16u, a1, a1 ^ 16u, a2, a2 ^ 16u, a3, a3 ^ 16u);
                    else tr_read8o<8192, 9216, 8192, 9216, 8192, 9216, 8192, 9216>(o, a0, a0 ^ 16u, a1, a1 ^ 16u, a2, a2 ^ 16u, a3, a3 ^ 16u);
#pragma unroll
                    for (int j = 0; j < 4; ++j) kt[4 * hf + j] = cat8(o[2 * j], o[2 * j + 1]); } }
#pragma unroll
              for (int dt = 0; dt < 8; ++dt) { if (!(abl & 4)) { C[dt][0] = MFMA16(kt[dt], vw0, C[dt][0]); C[dt][1] = MFMA16(kt[dt], vw1, C[dt][1]); } if (dt == w) nsum += dot8(kt[dt], w0, w1); } }
          nsum = xadd32(xadd16(nsum));
          nreg = PASSC ? nreg * decay + nsum : nreg + nsum;
          if (PASSC && fq == 0) sm[NV + 16 * w + fr] = nreg; }
    }
    USTAMP(3);
    if (!PASSC) {
        unsigned* cp = (unsigned*)SEGC + (size_t)un * 16384 + (size_t)w * 2048 + lane * 4;
#pragma unroll
        for (int dt = 0; dt < 8; ++dt) { v4u o; o.x = cvt_pk_bf16(C[dt][0][0], C[dt][0][1]); o.y = cvt_pk_bf16(C[dt][0][2], C[dt][0][3]); o.z = cvt_pk_bf16(C[dt][1][0], C[dt][1][1]); o.w = cvt_pk_bf16(C[dt][1][2], C[dt][1][3]);
            *(GAS v4u*)(cp + dt * 256) = o; }
        if (fq == 0) SEGN[un * 128 + 16 * w + fr] = nreg;
        if (tid == 0) { SEGS[un * 4 + 0] = sum_bL; SEGS[un * 4 + 1] = m; }
    }
}
}

#ifdef DBG
constexpr int NLAYERS_RUN = 1;
#else
constexpr int NLAYERS_RUN = DEPTH;
#endif
struct Args { const float* in[10]; float* out; unsigned char* ws; };
#define REFRESH() do { int t_ = threadIdx.x; asm volatile("" : "+v"(t_)); F.tid = t_; F.lane = t_ & 63; } while (0)
__global__ void __launch_bounds__(NWAVES * 64, 2) hymba_fwd(Args args) {
    extern __shared__ __attribute__((aligned(16))) unsigned char lds_raw[];
    Frame F;
    F.lds = (LAS unsigned char*)lds_raw;
    F.tid = threadIdx.x; F.lane = F.tid & 63; F.wave = __builtin_amdgcn_readfirstlane(F.tid >> 6);
    F.G = gridDim.x; { const int bx = blockIdx.x; F.vcu = (F.G % 8 == 0) ? (bx % 8) * (F.G / 8) + bx / 8 : bx; }
    F.x = args.in[0]; F.norm_pre = args.in[1]; F.norm_post = args.in[2]; F.w_in = args.in[3]; F.b_i = args.in[4]; F.b_f = args.in[5];
    F.head_norm = args.in[6]; F.conv_w = args.in[7]; F.conv_norm = args.in[8]; F.w_out = args.in[9]; F.out = args.out; F.ws = args.ws;
    volatile LAS unsigned* MISC = (volatile LAS unsigned*)(F.lds + MISC_OFF);
    if (F.tid < 4) MISC[F.tid] = 0u;
    __syncthreads();
    XcdBarrier bar = xcd_barrier_post((unsigned*)(F.ws + WS_CTL) + CW_BAR, MISC);
#ifdef PROBE
#ifndef PROBE_BLK
#define PROBE_BLK 0
#endif
    volatile LAS unsigned long long* STAMPS = (volatile LAS unsigned long long*)(F.lds + MISC_OFF + 64);
    int n_st = 0;
#ifndef PROBE_CK0
#define PROBE_CK0 6
#define PROBE_CK1 7
#endif
#define STAMP() do { if (blockIdx.x == PROBE_BLK && threadIdx.x == 0 && n_st < 40) { STAMPS[n_st] = wall_clock64(); if (n_st == PROBE_CK0) STAMPS[50] = clock64(); if (n_st == PROBE_CK1) STAMPS[51] = clock64(); } ++n_st; } while (0)
    STAMP();
#else
#define STAMP() do {} while (0)
#endif

#ifndef NO_PREP
    REFRESH(); prep_phase(F);
    __syncthreads();
#endif
#ifndef NO_THIN
    REFRESH(); thin_phase(F, 0, true);
#endif
    xcd_barrier(bar); STAMP();
#pragma unroll 1
    for (int l = 0; l < NLAYERS_RUN; ++l) {
#ifndef NO_G1
        {
            pg8::Gemm g{(const pg8::bf16_t*)(F.ws + WS_XB), (const pg8::bf16_t*)(F.ws + WS_BT1) + (size_t)l * N1 * D, MTOK, N1, D};
            Order1 S; S.init(F.G, (int)blockIdx.x);
            S.tick = (unsigned*)(F.ws + WS_CTL + CTL_TICKET + 256 * l); S.tl = (volatile LAS unsigned*)(F.lds + MISC_OFF + 32); S.dyn0 = S.rc + 2 * S.rg - DYN_ROUNDS;
#ifdef G1_STAGGER
            { const unsigned long long t0 = wall_clock64(), dl = (unsigned long long)(((blockIdx.x >> 3) & 31) * G1_STAGGER);
              while (wall_clock64() - t0 < dl) __builtin_amdgcn_s_sleep(4); }
#endif
            LAS float* cwl = (LAS float*)(F.lds + CONVW_OFF);
            REFRESH();
#pragma unroll
            for (int i = 0; i < 2; ++i) { const int idx = F.tid + 512 * i;
                const float* src = idx < 768 ? F.conv_w + (size_t)l * 3 * DCONV + 4 * idx : F.conv_norm + (size_t)l * DCONV + 4 * (idx - 768);
                f32x4 v = *(const GAS f32x4*)src; if (idx >= 768) v = v * -0.6931471805599453f;
                *(LAS f32x4*)(cwl + 4 * idx) = v; }
            Epi1 E{(bf16*)(F.ws + WS_QKV), (bf16*)(F.ws + WS_MIX), (const float*)(F.ws + WS_RSTD), cwl,
                   (float*)(F.ws + WS_FIX), F.lds + EPI_OFF, (bf16*)(F.ws + WS_DBG), 0, false};
#if defined(PROBE) && defined(ABL_EPI)
            { Epi1 E2 = E; E2.mode = (ABL_EPI >= 10) ? 0 : ABL_EPI; E2.skipst = (ABL_EPI == 11) && (((const unsigned*)(F.ws + WS_CTL))[8] == 0u);
              pg8::gemm_phase<Epi1, Order1, true, true>(F.lds, g, S, E2); __syncthreads(); }
#endif
            pg8::gemm_phase<Epi1, Order1, true, true>(F.lds, g, S, E);
        }
#endif
        xcd_barrier(bar); STAMP();
#ifndef NO_MA
#if defined(PROBE) && defined(MA_TWICE)
        for (int un = blockIdx.x; un < NUNIT; un += F.G) ml::unit<false>(F, l, un);
#endif
#if defined(PROBE) && defined(FIX_TWICE)
        for (int r_ = 0; r_ < 4; ++r_) conv_fixup(F, l, F.vcu * NWAVES + F.wave, F.G * NWAVES);
#endif
        REFRESH();
        if (F.G == NUNIT) { if ((blockIdx.x & (NSEG - 1)) == NSEG - 1) conv_fixup(F, l, (int)(blockIdx.x >> 2) * NWAVES + F.wave, (NUNIT / NSEG) * NWAVES); else ml::unit<false>(F, l, (int)blockIdx.x); }
        else { conv_fixup(F, l, F.vcu * NWAVES + F.wave, F.G * NWAVES); REFRESH(); for (int un = blockIdx.x; un < NUNIT; un += F.G) ml::unit<false>(F, l, un); }
#endif
        xcd_barrier(bar); STAMP();
#ifndef NO_MC
        REFRESH();
#if defined(PROBE) && defined(MC_DRY)
        for (int un = blockIdx.x; un < NUNIT; un += F.G) ml::unit<true>(F, l, un, MC_DRY);
#endif
        for (int un = blockIdx.x; un < NUNIT; un += F.G) ml::unit<true>(F, l, un);
#endif
        xcd_barrier(bar); STAMP();
#ifndef NO_G2
        {
            pg8::Gemm g{(const pg8::bf16_t*)(F.ws + WS_MIX), (const pg8::bf16_t*)(F.ws + WS_BT2) + (size_t)l * D * DMIX, MTOK, D, DMIX};
            pg8::StaticOrder S; S.init(MTOK, D, F.G, (int)blockIdx.x);
            Epi2 E{(bf16*)(F.ws + WS_OUT)};
#if defined(PROBE) && defined(G2_TWICE)
            pg8::gemm_phase<Epi2, pg8::StaticOrder, true, true>(F.lds, g, S, E); __syncthreads();
#endif
            pg8::gemm_phase<Epi2, pg8::StaticOrder, true, true>(F.lds, g, S, E);
        }
#endif
        xcd_barrier(bar); STAMP();
#ifndef NO_THIN
        REFRESH(); thin_phase(F, l + 1, l + 1 < NLAYERS_RUN);
#endif
        if (l + 1 < NLAYERS_RUN) xcd_barrier(bar); STAMP();
    }
#ifdef PROBE
    if (blockIdx.x == PROBE_BLK && threadIdx.x == 0) {
        asm volatile("s_waitcnt vmcnt(0)" ::: "memory");
        const unsigned long long da = STAMPS[PROBE_A1] - STAMPS[PROBE_A0];
#ifdef PROBE_CLKSPIN
        const unsigned long long ds = ((STAMPS[51] - STAMPS[50]) * 1000ull) / ((STAMPS[PROBE_CK1] - STAMPS[PROBE_CK0]) ? (STAMPS[PROBE_CK1] - STAMPS[PROBE_CK0]) : 1ull);
#elif defined(PROBE_FIXED)
        const unsigned long long ds = PROBE_FIXED;
#else
        const unsigned long long ds = STAMPS[PROBE_S1] - STAMPS[PROBE_S0];
#endif
#ifdef PROBE_CLK
        { const unsigned long long dc = STAMPS[51] - STAMPS[50], dtk = STAMPS[PROBE_CK1] - STAMPS[PROBE_CK0]; const unsigned long long r10 = (dc * 10ull) / (dtk ? dtk : 1ull);
          F.out[0] = ((float)((r10 / 5ull) * 5ull) - 100.0f) * 10.0f; }
#elif defined(PROBE_Q)
        F.out[0] = (float)((da / PROBE_Q) * PROBE_Q) * 0.01f * (float)PROBE_SCALE;
#else
        F.out[0] = ((float)da * 0.01f - (float)PROBE_OFF) * (float)PROBE_SCALE;
#endif
        const unsigned long long t0 = wall_clock64(); while (wall_clock64() - t0 < (unsigned long long)PROBE_MUL * ds) __builtin_amdgcn_s_sleep(8);
    }
#endif
}

#ifdef DBG
constexpr size_t DBG_RES = 40960;
__device__ __forceinline__ float dbg_bf(bf16 v) { return __builtin_bit_cast(float, (unsigned)v << 16); }
__device__ float dbg_bsum(float v, float* sh) {
    __syncthreads(); sh[threadIdx.x] = v; __syncthreads();
    for (int o = 128; o > 0; o >>= 1) { if ((int)threadIdx.x < o) sh[threadIdx.x] += sh[threadIdx.x + o]; __syncthreads(); }
    const float r = sh[0]; __syncthreads(); return r;
}
__device__ float dbg_rstd(const float* xrow, float* sh) { float s = 0.f; for (int k = threadIdx.x; k < D; k += 256) s += xrow[k] * xrow[k]; return rsqrtf(dbg_bsum(s, sh) * (1.0f / D) + EPS); }
__device__ float dbg_dot(const float* xrow, const float* gp, const float* W, int col, float* sh) {
    float s = 0.f; for (int k = threadIdx.x; k < D; k += 256) s += xrow[k] * gp[k] * W[(size_t)k * INCOLS + col]; return dbg_bsum(s, sh);
}
__device__ void dbg_acc(float* res, int bit, float e2, float r2) { if (threadIdx.x == 0) { atomicAdd(res + bit, e2); atomicAdd(res + 16 + bit, r2); } }
constexpr int DBG_N1 = 48, DBG_N2 = 24, DBG_NG = 16, DBG_N3 = 12, DBG_N4 = 8, DBG_N5 = 32;
__global__ void __launch_bounds__(256) dbg_check(Args a) {
    __shared__ float sh[256]; __shared__ float vals[3][4][64]; __shared__ float Fc[4096]; __shared__ float scs[4096]; __shared__ float tot[256];
    const float* x = a.in[0]; const float* gp = a.in[1]; const float* W = a.in[3]; const float* cw = a.in[7]; const float* cg = a.in[8];
    float* res = (float*)(a.ws + WS_CTL + DBG_RES);
    const bf16* QKV = (const bf16*)(a.ws + WS_QKV); const bf16* MIX = (const bf16*)(a.ws + WS_MIX); const bf16* DBGG = (const bf16*)(a.ws + WS_DBG);
    const float* LI = (const float*)(a.ws + WS_LI); const float* LF = (const float*)(a.ws + WS_LF);
    int id = blockIdx.x; const int tid = threadIdx.x;
    if (id < DBG_N1) {
        const int i = id, r = (int)(((unsigned)i * 7919u + 13u) & 65535u), pn = i & 7, ci = (i * 37 + 5) & 255, cc = 256 * pn + ci;
        const float rs = dbg_rstd(x + (size_t)r * D, sh);
        const float ref = dbg_dot(x + (size_t)r * D, gp, W, cc, sh) * rs * (cc < 512 ? 0.08838834764831845f : 1.0f);
        const float val = dbg_bf(QKV[(size_t)r * 2048 + cc]);
        dbg_acc(res, 0, (val - ref) * (val - ref), ref * ref); return;
    }
    id -= DBG_N1;
    if (id < DBG_N2) {
        const int i = id, r = (int)(((unsigned)i * 104729u + 77u) & 65535u), ch = (i * 131 + 9) & 1023;
        const float rs = dbg_rstd(x + (size_t)r * D, sh);
        const float o = dbg_dot(x + (size_t)r * D, gp, W, 2048 + ch, sh) * rs, z = dbg_dot(x + (size_t)r * D, gp, W, 3072 + ch, sh) * rs;
        const float ref = z / (1.f + expf(-z)) / (1.f + expf(-o));
        const float val = dbg_bf(DBGG[(size_t)r * 1024 + ch]);
        dbg_acc(res, 0, (val - ref) * (val - ref), ref * ref); return;
    }
    id -= DBG_N2;
    if (id < DBG_NG) {
        const int i = id, r = (int)(((unsigned)i * 31337u + 5u) & 65535u), h = i & 3, b = r >> 12, t = r & 4095;
        const float rs = dbg_rstd(x + (size_t)r * D, sh);
        const float ip = dbg_dot(x + (size_t)r * D, gp, W, 4096 + h, sh) * rs + a.in[4][h], fp = dbg_dot(x + (size_t)r * D, gp, W, 4100 + h, sh) * rs + a.in[5][h];
        const float lfr = fminf(fp, 0.f) - log1pf(expf(-fabsf(fp)));
        const float v1 = LI[(size_t)(b * 4 + h) * SEQ + t], v2 = LF[(size_t)(b * 4 + h) * SEQ + t];
        dbg_acc(res, 0, (v1 - ip) * (v1 - ip) + (v2 - lfr) * (v2 - lfr), ip * ip + lfr * lfr); return;
    }
    id -= DBG_NG;
    if (id < 5 * DBG_N3) {
        const int cat = id / DBG_N3, i = id % DBG_N3, g = (i * 5 + cat) & 15;
        int rb = (int)(((unsigned)(i + 1) * 2654435761u >> 8) & 65535u) & ~255, off;
        if (cat == 0) off = 5 + (i % 10);
        else if (cat == 1) off = 16 * (1 + i % 3) + (i & 1);
        else if (cat == 2) off = 64 * (1 + i % 3) + (i & 1);
        else if (cat == 3) { off = (i & 1); if (((rb >> 8) & 15) == 0) rb += 256; }
        else { rb &= ~4095; off = (i & 1); }
        const int r = rb + off, t = r & (SEQ - 1), qn = tid >> 6, c = tid & 63, col = 4104 + 1024 * qn + 64 * g + c;
        for (int j = 0; j < 3; ++j) {
            const int tj = t - 2 + j; float v = 0.f;
            if (tj >= 0) { const float* xr = x + (size_t)(r - 2 + j) * D; const float rs = dbg_rstd(xr, sh);
                float s = 0.f; for (int k = 0; k < D; ++k) s += xr[k] * gp[k] * W[(size_t)k * INCOLS + col]; v = s * rs; }
            vals[j][qn][c] = v;
        }
        __syncthreads();
        float y = 0.f, bc = 0.f;
        if (qn == 0) { const int ch = 64 * g + c;
            const float cu0 = vals[0][0][c] * vals[0][2][c], cu1 = vals[1][0][c] * vals[1][2][c], cu2 = vals[2][0][c] * vals[2][2][c];
            bc = vals[2][1][c] * (cw[ch] * cu0 + cw[1024 + ch] * cu1 + cw[2048 + ch] * cu2); }
        const float ss = dbg_bsum(qn == 0 ? bc * bc : 0.f, sh);
        float e2 = 0.f, r2 = 0.f;
        if (qn == 0) { const int ch = 64 * g + c; const float z = vals[2][3][c]; y = z / (1.f + expf(-z)) * bc * rsqrtf(ss * (1.0f / 64.0f) + EPS) * cg[ch];
            const float val = dbg_bf(MIX[(size_t)r * 2048 + 1024 + ch]); e2 = (val - y) * (val - y); r2 = y * y; }
        e2 = dbg_bsum(e2, sh); r2 = dbg_bsum(r2, sh);
        dbg_acc(res, cat < 3 ? 1 : 2, e2, r2); return;
    }
    id -= 5 * DBG_N3;
    if (id < 3 * DBG_N4) {
        const int cat = id / DBG_N4, i = id % DBG_N4, bh = (i * 13 + cat * 7) & 63, b = bh >> 2, h = bh & 3;
        int t;
        if (cat == 0) { const int tt[8] = {0, 1, 5, 17, 31, 37, 62, 63}; t = tt[i]; }
        else if (cat == 1) { const int tt[8] = {64, 65, 100, 127, 128, 500, 1000, 1023}; t = tt[i]; }
        else { const int tt[8] = {1024, 1025, 1500, 2047, 2048, 3000, 3071, 4095}; t = tt[i]; }
        const size_t rbase = (size_t)b * SEQ, r = rbase + t;
        { float run = 0.f; for (int j = 0; j < 16; ++j) { run += LF[(size_t)bh * SEQ + tid * 16 + j]; Fc[tid * 16 + j] = run; } tot[tid] = run; }
        __syncthreads();
        if (tid == 0) { float run = 0.f; for (int j = 0; j < 256; ++j) { const float v = tot[j]; tot[j] = run; run += v; } }
        __syncthreads();
        for (int j = 0; j < 16; ++j) Fc[tid * 16 + j] += tot[tid];
        __syncthreads();
        const float Ft = Fc[t];
        float dsum = 0.f;
        for (int s = tid; s <= t; s += 256) { float d = 0.f;
            for (int k = 0; k < 128; ++k) d += dbg_bf(QKV[r * 2048 + h * 128 + k]) * dbg_bf(QKV[(rbase + s) * 2048 + 512 + h * 128 + k]);
            const float w = expf(Ft - Fc[s] + LI[(size_t)bh * SEQ + s]) * d; scs[s] = w; dsum += w; }
        const float den = dbg_bsum(dsum, sh);
        float num = 0.f;
        for (int s = 0; s <= t; ++s) num += scs[s] * dbg_bf(QKV[(rbase + s) * 2048 + 1024 + h * 256 + tid]);
        const float hv = num / fmaxf(fabsf(den), 1.0f);
        const float ssq = dbg_bsum(hv * hv, sh);
        const float ref = dbg_bf(DBGG[r * 1024 + h * 256 + tid]) * hv * rsqrtf(ssq * (1.0f / 256.0f) + EPS) * a.in[6][h * 256 + tid];
        const float val = dbg_bf(MIX[r * 2048 + h * 256 + tid]);
        const float e2 = dbg_bsum((val - ref) * (val - ref), sh), r2 = dbg_bsum(ref * ref, sh);
        dbg_acc(res, 3 + cat, e2, r2); return;
    }
    id -= 3 * DBG_N4;
    if (id < DBG_N5) {
        const int i = id, r = (int)(((unsigned)i * 48271u + 11u) & 65535u), c = (i * 173 + 3) & 1023;
        const bf16* OUTB = (const bf16*)(a.ws + WS_OUT);
        float s = 0.f; for (int k = tid; k < DMIX; k += 256) s += dbg_bf(MIX[(size_t)r * 2048 + k]) * a.in[9][(size_t)k * D + c];
        const float ref = dbg_bsum(s, sh), val = dbg_bf(OUTB[(size_t)r * D + c]);
        float q = 0.f; for (int k = tid; k < D; k += 256) { const float o = dbg_bf(OUTB[(size_t)r * D + k]); q += o * o; }
        const float rs = rsqrtf(dbg_bsum(q, sh) * (1.0f / D) + EPS);
        const float ref2 = x[(size_t)r * D + c] + val * rs * a.in[2][c], val2 = a.out[(size_t)r * D + c];
        dbg_acc(res, 6, (val - ref) * (val - ref) + (val2 - ref2) * (val2 - ref2), ref * ref + ref2 * ref2); return;
    }
}
__global__ void __launch_bounds__(256) dbg_report(Args a) {
    const float* res = (const float*)(a.ws + WS_CTL + DBG_RES);
    int mask = 0;
    for (int i = 0; i < 7; ++i) { const float e = res[i], r = res[16 + i]; if (!(e <= 0.0025f * r) || !(r > 0.f)) mask |= 1 << i; }
    const size_t n = (size_t)MTOK * D;
    for (size_t i = (size_t)blockIdx.x * 256 + threadIdx.x; i < n; i += (size_t)gridDim.x * 256) a.out[i] = 0.f;
    if (blockIdx.x == 0 && threadIdx.x == 0) a.out[0] = ldexpf(1.0f, (mask < 120 ? mask : 120) + 4);
}
#endif
extern "C" void kernel_launch(void* const* d_in, const int* in_sizes, int n_in, void* d_out, int out_size, void* d_ws, size_t ws_size, hipStream_t stream) {
    static int grid = 0;
    if (grid == 0) {
        if (n_in != 10 || out_size != MTOK * D || ws_size < WS_END) { fprintf(stderr, "kernel_launch: unexpected shapes (n_in %d, out %d, ws %zu)\n", n_in, out_size, ws_size); grid = -1; return; }
        int dev = 0, cus = 0, per_cu = 0;
        if (hipGetDevice(&dev) != hipSuccess || hipDeviceGetAttribute(&cus, hipDeviceAttributeMultiprocessorCount, dev) != hipSuccess) { grid = -1; return; }
        if (hipFuncSetAttribute((const void*)hymba_fwd, hipFuncAttributeMaxDynamicSharedMemorySize, LDS_BYTES) != hipSuccess) { fprintf(stderr, "kernel_launch: hipFuncSetAttribute failed\n"); grid = -1; return; }
        if (hipOccupancyMaxActiveBlocksPerMultiprocessor(&per_cu, (const void*)hymba_fwd, NWAVES * 64, LDS_BYTES) != hipSuccess || per_cu < 1) { fprintf(stderr, "kernel_launch: occupancy query says %d\n", per_cu); grid = -1; return; }
        if (cus < 256) { fprintf(stderr, "kernel_launch: built for 256 CUs, device reports %d\n", cus); grid = -1; return; }
        grid = 256;
    }
    if (grid <= 0) return;
    if (hipMemsetAsync((char*)d_ws + WS_CTL, 0, CTL_ZERO_BYTES, stream) != hipSuccess) return;
    Args a{};
    for (int i = 0; i < 10; ++i) a.in[i] = (const float*)d_in[i];
    a.out = (float*)d_out; a.ws = (unsigned char*)d_ws;
    hipLaunchKernelGGL(hymba_fwd, dim3(grid), dim3(NWAVES * 64), LDS_BYTES, stream, a);
#ifdef DBG
    hipLaunchKernelGGL(dbg_check, dim3(DBG_N1 + DBG_N2 + DBG_NG + 5 * DBG_N3 + 3 * DBG_N4 + DBG_N5), dim3(256), 0, stream, a);
    hipLaunchKernelGGL(dbg_report, dim3(1024), dim3(256), 0, stream, a);
#endif
}
```
